# Optimizing an MI355X kernel written in HIP

```python
import jax, jax.numpy as jnp
from jax import lax
import numpy as np

D_MODEL = 1024
BATCH = 2
SEQ = 16384
DEPTH = 2

SC_WIDTH = D_MODEL // 4
SC_GROUPS = 4
SC_KERNEL = 3
SB_HEAD_DIM = 64
SB_HEADS = (D_MODEL // 4) // SB_HEAD_DIM
SB_WIDTH = SB_HEADS * SB_HEAD_DIM
SB_BLOCK = 128
SSM_INNER = D_MODEL // 2
SSM_HEAD_DIM = 64
SSM_HEADS = SSM_INNER // SSM_HEAD_DIM
SSM_GROUPS = 2
SSM_STATE = 64
SSM_CONV = 4
SSM_CHUNK = 256
SSM_CONV_DIM = SSM_INNER + 2 * SSM_GROUPS * SSM_STATE
N_BRANCH = 3
FFN_HIDDEN = -(-8 * D_MODEL // (3 * 256)) * 256
NORM_EPS = 1e-6
N_MOD = 6
PROJ_SIZES = (SC_WIDTH, SC_WIDTH, SC_WIDTH,
              SB_WIDTH, SB_WIDTH, SB_WIDTH,
              SSM_INNER, SSM_CONV_DIM, SSM_HEADS,
              D_MODEL, D_MODEL, D_MODEL)
IN_PROJ = sum(PROJ_SIZES)

kernel_name = "hybrid_shortconv_stickbreak_ssd_block"


def rms_norm(x, g):
    x32 = x.astype(jnp.float32)
    y = x32 * lax.rsqrt(jnp.mean(x32 * x32, axis=-1, keepdims=True) + NORM_EPS)
    return (y * g.astype(jnp.float32)).astype(x.dtype)


def causal_depthwise_conv(x, w):
    k = w.shape[0]
    return lax.conv_general_dilated(
        x, w[:, None, :].astype(x.dtype), window_strides=(1,), padding=[(k - 1, 0)],
        dimension_numbers=("NWC", "WIO", "NWC"), feature_group_count=x.shape[-1])


def split_columns(p):
    offsets = [int(o) for o in np.cumsum(PROJ_SIZES)[:-1]]
    return jnp.split(p, offsets, axis=-1)


def short_conv_mixer(b_gate, c_gate, xa, w_conv):
    return b_gate * causal_depthwise_conv(c_gate * xa, w_conv)


def stick_breaking_attention(q, k, v):
    bsz, seq, heads, dh = q.shape
    n_blk = seq // SB_BLOCK
    scale = dh ** -0.5
    qh = q.transpose(0, 2, 1, 3)
    kh = k.transpose(0, 2, 1, 3)
    vh = v.transpose(0, 2, 1, 3)
    strict = jnp.tril(jnp.ones((SB_BLOCK, SB_BLOCK), jnp.float32), -1)
    outs = []
    for i in range(n_blk):
        start, end = i * SB_BLOCK, (i + 1) * SB_BLOCK
        z = jnp.einsum("bhqd,bhkd->bhqk", qh[:, :, start:end], kh[:, :, :end],
                       preferred_element_type=jnp.float32) * scale
        mask = jnp.arange(end)[None, :] < (start + jnp.arange(SB_BLOCK))[:, None]
        log_keep = jnp.where(mask, jax.nn.log_sigmoid(-z), 0.0)
        lk = log_keep.reshape(bsz, heads, SB_BLOCK, i + 1, SB_BLOCK)
        within = jnp.einsum("bhqcj,js->bhqcs", lk, strict)
        blk_tot = jnp.sum(lk, axis=-1)
        later = lax.cumsum(blk_tot, axis=3, reverse=True) - blk_tot
        log_rest = (within + later[..., None]).reshape(bsz, heads, SB_BLOCK, end)
        att = jnp.exp(jnp.where(mask, z + log_keep + log_rest, -jnp.inf))
        outs.append(jnp.einsum("bhqk,bhkd->bhqd", att.astype(vh.dtype), vh[:, :, :end]))
    out = jnp.concatenate(outs, axis=2)
    return out.transpose(0, 2, 1, 3).reshape(bsz, seq, heads * dh)


def segsum_exp(a_cs):
    l = a_cs.shape[-1]
    mask = jnp.tril(jnp.ones((l, l), dtype=bool))
    diff = a_cs[..., :, None] - a_cs[..., None, :]
    return jnp.exp(jnp.where(mask, diff, -jnp.inf))


def ssd_scan(xh, dt, a_neg, bm, cm):
    bsz, seq, heads, hd = xh.shape
    reps = heads // bm.shape[2]
    bh = jnp.repeat(bm, reps, axis=2)
    ch = jnp.repeat(cm, reps, axis=2)
    xdt = xh * dt[..., None]
    a = dt * a_neg
    pad = (-seq) % SSM_CHUNK
    if pad:
        pw = ((0, 0), (0, pad), (0, 0), (0, 0))
        xdt, bh, ch = jnp.pad(xdt, pw), jnp.pad(bh, pw), jnp.pad(ch, pw)
        a = jnp.pad(a, ((0, 0), (0, pad), (0, 0)))
    n_c = (seq + pad) // SSM_CHUNK
    xc = xdt.reshape(bsz, n_c, SSM_CHUNK, heads, hd)
    bc = bh.reshape(bsz, n_c, SSM_CHUNK, heads, -1)
    cc = ch.reshape(bsz, n_c, SSM_CHUNK, heads, -1)
    a_cs = jnp.cumsum(a.reshape(bsz, n_c, SSM_CHUNK, heads), axis=2)
    decay_in = segsum_exp(a_cs.transpose(0, 1, 3, 2))
    scores = jnp.einsum("bclhn,bcshn->bchls", cc, bc) * decay_in
    y_diag = jnp.einsum("bchls,bcshp->bclhp", scores, xc)
    decay_to_end = jnp.exp(a_cs[:, :, -1:, :] - a_cs)
    chunk_states = jnp.einsum("bclhn,bclhp->bchpn", bc * decay_to_end[..., None], xc)
    chunk_decay = jnp.exp(a_cs[:, :, -1, :])

    def step(state, inp):
        s_c, d_c = inp
        return state * d_c[..., None, None] + s_c, state

    init = jnp.zeros((bsz, heads, hd, bc.shape[-1]), jnp.float32)
    _, prev = lax.scan(step, init, (chunk_states.transpose(1, 0, 2, 3, 4),
                                    chunk_decay.transpose(1, 0, 2)))
    prev = prev.transpose(1, 0, 2, 3, 4)
    y_off = jnp.einsum("bclhn,bchpn->bclhp", cc, prev) * jnp.exp(a_cs)[..., None]
    return (y_diag + y_off).reshape(bsz, seq + pad, heads, hd)[:, :seq]


def mamba2_mixer(z, xbc, dt_raw, conv_w, conv_b, dt_bias, a_log, d_skip, norm_w):
    xbc = jax.nn.silu(causal_depthwise_conv(xbc, conv_w) + conv_b)
    xs, bm, cm = jnp.split(xbc, [SSM_INNER, SSM_INNER + SSM_GROUPS * SSM_STATE], axis=-1)
    bsz, seq, _ = xs.shape
    xh = xs.reshape(bsz, seq, SSM_HEADS, SSM_HEAD_DIM).astype(jnp.float32)
    bm = bm.reshape(bsz, seq, SSM_GROUPS, SSM_STATE).astype(jnp.float32)
    cm = cm.reshape(bsz, seq, SSM_GROUPS, SSM_STATE).astype(jnp.float32)
    dt = jax.nn.softplus(dt_raw.astype(jnp.float32) + dt_bias.astype(jnp.float32))
    a_neg = -jnp.exp(a_log.astype(jnp.float32))
    y = ssd_scan(xh, dt, a_neg, bm, cm) + xh * d_skip.astype(jnp.float32)[:, None]
    y = y.reshape(bsz, seq, SSM_INNER) * jax.nn.silu(z.astype(jnp.float32))
    yg = y.reshape(bsz, seq, SSM_GROUPS, SSM_INNER // SSM_GROUPS)
    yg = yg * lax.rsqrt(jnp.mean(yg * yg, axis=-1, keepdims=True) + NORM_EPS)
    return (yg.reshape(bsz, seq, SSM_INNER) * norm_w.astype(jnp.float32)).astype(z.dtype)


def hybrid_layer(x, c, mod_w, mod_b, g_pre_mix, g_post_mix, g_pre_ffn, g_post_ffn,
                 w_in, sc_conv_w, ssm_conv_w, ssm_conv_b, ssm_dt_bias, ssm_a_log, ssm_d,
                 ssm_norm_w, w_sc_out, w_sb_out, w_ssm_out, w_o, w_ffn_in, w_ffn_out):
    bsz, seq, _ = x.shape
    mod = jax.nn.silu(c) @ mod_w + mod_b
    shift1, scale1, gate1, shift2, scale2, gate2 = [m[:, None, :] for m in jnp.split(mod, N_MOD, axis=-1)]

    h = rms_norm(x, g_pre_mix) * (1 + scale1) + shift1
    (sc_b, sc_c, sc_x, q, k, v, z, xbc, dt_raw,
     gl_a, gl_b, gl_c) = split_columns(h @ w_in)
    y_a = short_conv_mixer(sc_b, sc_c, sc_x, sc_conv_w) @ w_sc_out
    y_b = stick_breaking_attention(
        q.reshape(bsz, seq, SB_HEADS, SB_HEAD_DIM),
        k.reshape(bsz, seq, SB_HEADS, SB_HEAD_DIM),
        v.reshape(bsz, seq, SB_HEADS, SB_HEAD_DIM)) @ w_sb_out
    y_c = mamba2_mixer(z, xbc, dt_raw, ssm_conv_w, ssm_conv_b, ssm_dt_bias, ssm_a_log,
                       ssm_d, ssm_norm_w) @ w_ssm_out
    merged = (jax.nn.sigmoid(gl_a) * y_a + jax.nn.sigmoid(gl_b) * y_b
              + jax.nn.sigmoid(gl_c) * y_c)
    mix_out = merged @ w_o
    x = x + (gate1 * rms_norm(mix_out, g_post_mix)).astype(x.dtype)

    h2 = rms_norm(x, g_pre_ffn) * (1 + scale2) + shift2
    gt, up = jnp.split(h2 @ w_ffn_in, 2, axis=-1)
    f = (jax.nn.silu(gt) * up) @ w_ffn_out
    x = x + (gate2 * rms_norm(f, g_post_ffn)).astype(x.dtype)
    return x


def setup_inputs(seed: int = 0) -> dict:
    key = jax.random.key(seed)
    ks = jax.random.split(key, 24)
    f32 = jnp.float32

    def nrm(k, shape, fan_in):
        return jax.random.normal(k, shape, f32) * (fan_in ** -0.5)

    def gain(k, shape):
        return 1.0 + 0.05 * jax.random.normal(k, shape, f32)

    dt0 = jnp.exp(jax.random.uniform(ks[14], (DEPTH, SSM_HEADS), f32,
                                     jnp.log(1e-3), jnp.log(1e-1)))
    return {
        "x": jax.random.normal(ks[0], (BATCH, SEQ, D_MODEL), f32),
        "c": jax.random.normal(ks[1], (BATCH, D_MODEL), f32),
        "mod_w": nrm(ks[2], (DEPTH, D_MODEL, N_MOD * D_MODEL), D_MODEL),
        "mod_b": 0.02 * jax.random.normal(ks[3], (DEPTH, N_MOD * D_MODEL), f32),
        "g_pre_mix": gain(ks[4], (DEPTH, D_MODEL)),
        "g_post_mix": gain(ks[5], (DEPTH, D_MODEL)),
        "g_pre_ffn": gain(ks[6], (DEPTH, D_MODEL)),
        "g_post_ffn": gain(ks[7], (DEPTH, D_MODEL)),
        "w_in": nrm(ks[8], (DEPTH, D_MODEL, IN_PROJ), D_MODEL),
        "sc_conv_w": nrm(ks[9], (DEPTH, SC_KERNEL, SC_WIDTH), SC_KERNEL),
        "ssm_conv_w": nrm(ks[10], (DEPTH, SSM_CONV, SSM_CONV_DIM), SSM_CONV),
        "ssm_conv_b": 0.02 * jax.random.normal(ks[11], (DEPTH, SSM_CONV_DIM), f32),
        "ssm_dt_bias": dt0 + jnp.log(-jnp.expm1(-dt0)),
        "ssm_a_log": jnp.log(jax.random.uniform(ks[12], (DEPTH, SSM_HEADS), f32, 1.0, 16.0)),
        "ssm_d": 1.0 + 0.1 * jax.random.normal(ks[13], (DEPTH, SSM_HEADS), f32),
        "ssm_norm_w": gain(ks[15], (DEPTH, SSM_INNER)),
        "w_sc_out": nrm(ks[16], (DEPTH, SC_WIDTH, D_MODEL), SC_WIDTH),
        "w_sb_out": nrm(ks[17], (DEPTH, SB_WIDTH, D_MODEL), SB_WIDTH),
        "w_ssm_out": nrm(ks[18], (DEPTH, SSM_INNER, D_MODEL), SSM_INNER),
        "w_o": nrm(ks[19], (DEPTH, D_MODEL, D_MODEL), D_MODEL),
        "w_ffn_in": nrm(ks[20], (DEPTH, D_MODEL, 2 * FFN_HIDDEN), D_MODEL),
        "w_ffn_out": nrm(ks[21], (DEPTH, FFN_HIDDEN, D_MODEL), FFN_HIDDEN),
    }


def reference(x, c, mod_w, mod_b, g_pre_mix, g_post_mix, g_pre_ffn, g_post_ffn, w_in,
              sc_conv_w, ssm_conv_w, ssm_conv_b, ssm_dt_bias, ssm_a_log, ssm_d, ssm_norm_w,
              w_sc_out, w_sb_out, w_ssm_out, w_o, w_ffn_in, w_ffn_out):
    for l in range(DEPTH):
        x = hybrid_layer(x, c, mod_w[l], mod_b[l], g_pre_mix[l], g_post_mix[l],
                         g_pre_ffn[l], g_post_ffn[l], w_in[l], sc_conv_w[l], ssm_conv_w[l],
                         ssm_conv_b[l], ssm_dt_bias[l], ssm_a_log[l], ssm_d[l], ssm_norm_w[l],
                         w_sc_out[l], w_sb_out[l], w_ssm_out[l], w_o[l], w_ffn_in[l],
                         w_ffn_out[l])
    return x
```

```cpp
#include <hip/hip_runtime.h>
#include <hip/hip_cooperative_groups.h>
#include <cstdio>
#include <cstdint>
namespace cg = cooperative_groups;

#define LAS __attribute__((address_space(3)))
typedef unsigned short bf16_t;
typedef short bf16x8 __attribute__((ext_vector_type(8)));
typedef float f32x4 __attribute__((ext_vector_type(4)));
typedef float f32x2 __attribute__((ext_vector_type(2)));
typedef unsigned u32x4 __attribute__((ext_vector_type(4)));
typedef unsigned u32x2 __attribute__((ext_vector_type(2)));

constexpr int BATCH = 2, SEQ = 16384, D = 1024, M = BATCH * SEQ, DEPTH = 2;
constexpr int NSRC = 5896;
constexpr int NP = 5888;
constexpr int NPAD = 6144;
constexpr int FFN = 2816;
constexpr float EPS = 1e-6f;
constexpr int YP = 1024, QP = 1792, GP = 3072;
constexpr size_t Y_OFF = 0, Q_OFF = (size_t)M * YP, G_OFF = Q_OFF + (size_t)M * QP;
constexpr int YC_A = 0, YC_B = 256, YC_C = 512, QC_SCC = 0, QC_SCX = 256, QC_K = 512, QC_V = 768, QC_XBC = 1024;
static_assert((G_OFF + (size_t)M * GP) * 2 == (size_t)M * NP * 2, "region size");
constexpr int SSD_CH = 64, SSD_NCH = SEQ / SSD_CH;

constexpr size_t MiB = 1u << 20;
constexpr size_t WS_MOD = 0;
constexpr size_t WS_CD = 128 * 1024;
constexpr size_t WS_BAR = 512 * 1024;
constexpr size_t WS_DT = 1 * MiB;
constexpr size_t WS_W = 2 * MiB;
constexpr size_t W_LAYER = 33 * MiB, W_IN = 0, W_OUT3 = 12 * MiB, W_O = 14 * MiB, W_FI = 16 * MiB, W_FO = 27 * MiB;
constexpr size_t WS_P = 68 * MiB;
constexpr size_t WS_HM = 436 * MiB;
constexpr size_t WS_XBUF = 500 * MiB;
constexpr size_t WS_PCNT = 512 * 1024 + 16384;
constexpr size_t WS_END = 504 * MiB;
constexpr size_t P_H2 = 64 * MiB, P_ACT = 128 * MiB;

enum { IN_X = 0, IN_C, IN_MODW, IN_MODB, IN_GPM, IN_GPOM, IN_GPF, IN_GPOF, IN_WIN, IN_SCW, IN_SSMCW, IN_SSMCB, IN_DTB, IN_ALOG, IN_SSMD, IN_SSMNW, IN_WSC, IN_WSB, IN_WSSM, IN_WO, IN_WFI, IN_WFO };

struct Args { const float* in[22]; float* out; unsigned char* ws; int pad0, pad1; };
typedef const __attribute__((address_space(4))) Args* KA;
__device__ __forceinline__ KA ka_fresh() { KA p = (KA)__builtin_amdgcn_kernarg_segment_ptr(); asm volatile("" : "+s"(p)); return p; }

__device__ __forceinline__ float bf2f(bf16_t v) { return __uint_as_float((unsigned)v << 16); }
__device__ __forceinline__ float bflo(unsigned u) { return __uint_as_float(u << 16); }
__device__ __forceinline__ float bfhi(unsigned u) { return __uint_as_float(u & 0xffff0000u); }
__device__ __forceinline__ unsigned f2bf(float f) { unsigned u = __float_as_uint(f); return (u + 0x7fffu + ((u >> 16) & 1u)) >> 16; }
typedef __bf16 bf16x2_t __attribute__((ext_vector_type(2)));
__device__ __forceinline__ unsigned pk2(float lo, float hi) { f32x2 v = {lo, hi}; const bf16x2_t b = __builtin_convertvector(v, bf16x2_t); return __builtin_bit_cast(unsigned, b); }
__device__ __forceinline__ float wave_sum(float v) {
#pragma unroll
    for (int o = 1; o < 64; o <<= 1) v += __shfl_xor(v, o);
    return v;
}
__device__ __forceinline__ float sigmoidf_(float v) { return __builtin_amdgcn_rcpf(1.f + __expf(-v)); }
__device__ __forceinline__ float siluf_(float v) { return v * sigmoidf_(v); }
__device__ __forceinline__ float softplusf_(float z) { return fmaxf(z, 0.f) + __logf(1.f + __expf(-fabsf(z))); }
#define LDS_WAIT() asm volatile("s_waitcnt lgkmcnt(0)" ::: "memory")

namespace pg8 {
constexpr int BM = 256, BK = 64, HALF = 128, HTB = HALF * BK * 2, STAGE_BYTES = 8 * HTB, NXCD = 8, WGM = 4;
__device__ __forceinline__ int lds_byte(int r, int c) { const int st = (r >> 4) * 2 + (c >> 5), rr = r & 15, cc = c & 31, ob = rr * 64 + cc * 2; return st * 1024 + (ob ^ (((ob >> 9) & 1) << 5)); }
__device__ __forceinline__ void stage_rc(int b, int& R, int& C) { const int st = b / 1024, sb = b % 1024, swz = sb ^ (((sb >> 9) & 1) << 5); R = (st >> 1) * 16 + swz / 64; C = (st & 1) * 32 + (swz % 64) / 2; }
__device__ __forceinline__ int perm32(int rho) { const int n = rho >> 4, i = rho & 15; return 8 * (i >> 2) + 4 * n + (i & 3); }

struct Unit { int pm, pn; };
struct Gemm { const bf16_t* A; const bf16_t* Bt; int M, N, K, lda, ldb; };

struct StaticOrder {
    int nM, nN, nwg, G, c;
    __device__ void init(int M_, int N_, int G_, int c_) { nM = M_ / BM; nN = N_ / BM; nwg = nM * nN; asm volatile("" : "+s"(G_), "+s"(c_)); G = G_; c = c_; }
    __device__ bool next(int i, Unit& u) const {
        const long L = (long)i * G + c; if (L >= nwg) return false;
        int wgid = (int)L; { const int q = nwg / NXCD, r = nwg % NXCD, xcd = wgid % NXCD, off = wgid / NXCD; wgid = (xcd < r ? xcd * (q + 1) : r * (q + 1) + (xcd - r) * q) + off; }
        const int nig = WGM * nN, gid = wgid / nig, fm = gid * WGM, gsz = (nM - fm) < WGM ? (nM - fm) : WGM;
        u.pm = fm + ((wgid % nig) % gsz); u.pn = (wgid % nig) / gsz; return true;
    }
};


struct EpiProj {
    static constexpr bool FUSED = false, HOOK = false; bf16_t* P; float* DT;
    __device__ __forceinline__ void operator()(const f32x4 (&acc)[2][2][4][2], const Unit& u, int wr, int wc, int fr, int fq) const {
        asm volatile("" : "+v"(fr), "+v"(fq));
        const int row0 = u.pm * BM + wr * 64 + fr;
        if (u.pn == 23) {
            if (wc == 0 && fq == 0) {
#pragma unroll
                for (int ai = 0; ai < 2; ++ai)
#pragma unroll
                    for (int m = 0; m < 4; ++m) { float* d = DT + (size_t)(row0 + ai * HALF + m * 16) * 8;
                        *(f32x4*)d = acc[ai][0][m][0]; *(f32x4*)(d + 4) = acc[ai][0][m][1]; }
            }
            return;
        }
        bf16_t* base; int pitch, cb;
        if (u.pn < 4) { base = P + Y_OFF; pitch = YP; cb = u.pn * BM; } else if (u.pn < 11) { base = P + Q_OFF; pitch = QP; cb = (u.pn - 4) * BM; } else { base = P + G_OFF; pitch = GP; cb = (u.pn - 11) * BM; }
        const int col0 = cb + wc * 32 + 8 * fq;
#pragma unroll
        for (int ai = 0; ai < 2; ++ai)
#pragma unroll
            for (int m = 0; m < 4; ++m) { bf16_t* rowp = base + (size_t)(row0 + ai * HALF + m * 16) * pitch + col0;
#pragma unroll
                for (int bj = 0; bj < 2; ++bj) { const f32x4 v0 = acc[ai][bj][m][0], v1 = acc[ai][bj][m][1];
                    u32x4 w; w.x = pk2(v0[0], v0[1]); w.y = pk2(v0[2], v0[3]); w.z = pk2(v1[0], v1[1]); w.w = pk2(v1[2], v1[3]);
                    *(u32x4*)(rowp + bj * HALF) = w; } }
    }
};

struct EpiGate3 {
    static constexpr bool FUSED = false, HOOK = true;
    bf16_t* O; const bf16_t* G;
    static __device__ __forceinline__ float en(float g) { return __expf(fminf(-g, 60.f)); }
    __device__ __forceinline__ void hook(f32x4 (&acc)[2][2][4][2], const Unit& u, int t, int wr, int wc, int fr, int fq) const {
        asm volatile("" : "+v"(fr), "+v"(fq));
        const int row0 = u.pm * BM + wr * 64 + fr, col0 = u.pn * BM + wc * 32 + 8 * fq;
        const bf16_t* gp = G + (t == 4 ? 0 : 1024);
#pragma unroll
        for (int ai = 0; ai < 2; ++ai)
#pragma unroll
            for (int m = 0; m < 4; ++m) { const size_t row = (size_t)(row0 + ai * HALF + m * 16);
#pragma unroll
                for (int bj = 0; bj < 2; ++bj) { const bf16_t* p = gp + row * GP + col0 + bj * HALF;
                    const u32x4 a = *(const u32x4*)p, b = *(const u32x4*)(p + 1024);
                    f32x4 r0, r1;
                    r0[0] = (1.f + en(bflo(b.x))) * __builtin_amdgcn_rcpf(1.f + en(bflo(a.x))); r0[1] = (1.f + en(bfhi(b.x))) * __builtin_amdgcn_rcpf(1.f + en(bfhi(a.x)));
                    r0[2] = (1.f + en(bflo(b.y))) * __builtin_amdgcn_rcpf(1.f + en(bflo(a.y))); r0[3] = (1.f + en(bfhi(b.y))) * __builtin_amdgcn_rcpf(1.f + en(bfhi(a.y)));
                    r1[0] = (1.f + en(bflo(b.z))) * __builtin_amdgcn_rcpf(1.f + en(bflo(a.z))); r1[1] = (1.f + en(bfhi(b.z))) * __builtin_amdgcn_rcpf(1.f + en(bfhi(a.z)));
                    r1[2] = (1.f + en(bflo(b.w))) * __builtin_amdgcn_rcpf(1.f + en(bflo(a.w))); r1[3] = (1.f + en(bfhi(b.w))) * __builtin_amdgcn_rcpf(1.f + en(bfhi(a.w)));
                    acc[ai][bj][m][0] *= r0; acc[ai][bj][m][1] *= r1; }
                asm volatile("" ::: "memory"); }
    }
    __device__ __forceinline__ void operator()(const f32x4 (&acc)[2][2][4][2], const Unit& u, int wr, int wc, int fr, int fq) const {
        asm volatile("" : "+v"(fr), "+v"(fq));
        const int row0 = u.pm * BM + wr * 64 + fr, col0 = u.pn * BM + wc * 32 + 8 * fq;
#pragma unroll
        for (int ai = 0; ai < 2; ++ai)
#pragma unroll
            for (int m = 0; m < 4; ++m) { const size_t row = (size_t)(row0 + ai * HALF + m * 16);
#pragma unroll
                for (int bj = 0; bj < 2; ++bj) { const f32x4 v0 = acc[ai][bj][m][0], v1 = acc[ai][bj][m][1];
                    const u32x4 g = *(const u32x4*)(G + 2048 + row * GP + col0 + bj * HALF);
                    u32x4 w;
                    w.x = pk2(v0[0] * __builtin_amdgcn_rcpf(1.f + en(bflo(g.x))), v0[1] * __builtin_amdgcn_rcpf(1.f + en(bfhi(g.x)))); w.y = pk2(v0[2] * __builtin_amdgcn_rcpf(1.f + en(bflo(g.y))), v0[3] * __builtin_amdgcn_rcpf(1.f + en(bfhi(g.y))));
                    w.z = pk2(v1[0] * __builtin_amdgcn_rcpf(1.f + en(bflo(g.z))), v1[1] * __builtin_amdgcn_rcpf(1.f + en(bfhi(g.z)))); w.w = pk2(v1[2] * __builtin_amdgcn_rcpf(1.f + en(bflo(g.w))), v1[3] * __builtin_amdgcn_rcpf(1.f + en(bfhi(g.w))));
                    *(u32x4*)(O + row * D + col0 + bj * HALF) = w; }
                asm volatile("" ::: "memory"); }
    }
};
struct EpiSwiGLU {
    static constexpr bool FUSED = false, HOOK = false; bf16_t* O;
    __device__ __forceinline__ void operator()(const f32x4 (&acc)[2][2][4][2], const Unit& u, int wr, int wc, int fr, int fq) const {
        asm volatile("" : "+v"(fr), "+v"(fq));
        const int row0 = u.pm * BM + wr * 64 + fr, col0 = u.pn * HALF + wc * 32 + 8 * fq;
#pragma unroll
        for (int ai = 0; ai < 2; ++ai)
#pragma unroll
            for (int m = 0; m < 4; ++m) { bf16_t* rowp = O + (size_t)(row0 + ai * HALF + m * 16) * FFN + col0;
                const f32x4 g0 = acc[ai][0][m][0], g1 = acc[ai][0][m][1], u0 = acc[ai][1][m][0], u1 = acc[ai][1][m][1];
                u32x4 w; w.x = pk2(siluf_(g0[0]) * u0[0], siluf_(g0[1]) * u0[1]); w.y = pk2(siluf_(g0[2]) * u0[2], siluf_(g0[3]) * u0[3]);
                w.z = pk2(siluf_(g1[0]) * u1[0], siluf_(g1[1]) * u1[1]); w.w = pk2(siluf_(g1[2]) * u1[2], siluf_(g1[3]) * u1[3]);
                *(u32x4*)rowp = w; }
    }
};


struct PanelSq {
    float* xbuf;
    unsigned* cnt;
    unsigned need;
    __device__ __forceinline__ void run(const f32x4 (&v)[2][2][4][2], const Unit& u, int wr, int wc, int fr, int fq, LAS unsigned char* ldsx, int wid, int lane) const {
        LAS float* Pp = (LAS float*)ldsx; LAS float* S = (LAS float*)(ldsx + 4096);
#pragma unroll
        for (int ai = 0; ai < 2; ++ai)
#pragma unroll
            for (int m = 0; m < 4; ++m) {
                float q = 0.f;
#pragma unroll
                for (int bj = 0; bj < 2; ++bj)
#pragma unroll
                    for (int n = 0; n < 2; ++n) { const f32x4 x = v[ai][bj][m][n]; q += (x[0] * x[0] + x[1] * x[1]) + (x[2] * x[2] + x[3] * x[3]); }
                q += __shfl_xor(q, 16); q += __shfl_xor(q, 32);
                if (fq == 0) Pp[(ai * HALF + wr * 64 + m * 16 + fr) * 4 + wc] = q;
            }
        asm volatile("s_waitcnt lgkmcnt(0)" ::: "memory"); __builtin_amdgcn_s_barrier(); asm volatile("" ::: "memory");
        const int row = wid * 32 + (lane & 31);
        if (lane < 32) {
            const float q = (Pp[row * 4 + 0] + Pp[row * 4 + 1]) + (Pp[row * 4 + 2] + Pp[row * 4 + 3]);
            __hip_atomic_store(xbuf + ((size_t)(u.pm * BM + row) * 4 + u.pn), q, __ATOMIC_RELAXED, __HIP_MEMORY_SCOPE_AGENT);
        }
        asm volatile("s_waitcnt vmcnt(0)" ::: "memory");
        if (lane == 0) __hip_atomic_fetch_add(cnt + 64 * u.pm, 1u, __ATOMIC_RELAXED, __HIP_MEMORY_SCOPE_AGENT);
        if (wid == 0) {
            unsigned sp = 0;
            while ((unsigned)__builtin_amdgcn_readfirstlane(__hip_atomic_load(cnt + 64 * u.pm, __ATOMIC_RELAXED, __HIP_MEMORY_SCOPE_AGENT)) < need) { __builtin_amdgcn_s_sleep(2); if (++sp > (1u << 22)) break; }
            __builtin_amdgcn_fence(__ATOMIC_ACQUIRE, "agent");
        }
        asm volatile("s_waitcnt vmcnt(0) lgkmcnt(0)" ::: "memory"); __builtin_amdgcn_s_barrier(); asm volatile("" ::: "memory");
        if (lane < 32) {
            const float* slot = xbuf + (size_t)(u.pm * BM + row) * 4; float t = 0.f;
#pragma unroll
            for (int k = 0; k < 4; ++k) t += __hip_atomic_load(slot + k, __ATOMIC_RELAXED, __HIP_MEMORY_SCOPE_AGENT);
            S[row] = t;
        }
        asm volatile("s_waitcnt lgkmcnt(0)" ::: "memory"); __builtin_amdgcn_s_barrier(); asm volatile("" ::: "memory");
    }
};
template <bool XIN_BF16, bool XOUT_BF16> struct EpiResNorm {
    static constexpr bool FUSED = true, HOOK = false;
    __device__ __forceinline__ void load8(size_t off, f32x4& v0, f32x4& v1) const {
        if (XIN_BF16) { const u32x4 w = *(const u32x4*)((const bf16_t*)xin + off); v0 = (f32x4){bflo(w.x), bfhi(w.x), bflo(w.y), bfhi(w.y)}; v1 = (f32x4){bflo(w.z), bfhi(w.z), bflo(w.w), bfhi(w.w)}; }
        else { v0 = *(const f32x4*)((const float*)xin + off); v1 = *(const f32x4*)((const float*)xin + off + 4); } }
    __device__ __forceinline__ void store8(size_t off, const f32x4& v0, const f32x4& v1) const {
        if (XOUT_BF16) { u32x4 w; w.x = pk2(v0[0], v0[1]); w.y = pk2(v0[2], v0[3]); w.z = pk2(v1[0], v1[1]); w.w = pk2(v1[2], v1[3]); *(u32x4*)((bf16_t*)xout + off) = w; }
        else { *(f32x4*)((float*)xout + off) = v0; *(f32x4*)((float*)xout + off + 4) = v1; } }
    const void* xin; void* xout; const float* gate; const float* gpost; int do_next; const float* gn; const float* scn; const float* shn; bf16_t* hout; PanelSq st1, st2;
    __device__ __forceinline__ void fused(f32x4 (&acc)[2][2][4][2], const Unit& u, int wr, int wc, int fr, int fq, LAS unsigned char* ldsx, int wid, int lane) const {
        asm volatile("" : "+v"(fr), "+v"(fq));
        const LAS float* S = (const LAS float*)(ldsx + 4096);
        const int col0 = u.pn * BM + wc * 32 + 8 * fq;
        const int boff = (u.pm * BM >= SEQ) ? 6144 : 0;
        const float* gate = this->gate + boff; const float* scn = this->scn + boff; const float* shn = this->shn + boff;
        f32x4 g1[2][2];
#pragma unroll
        for (int bj = 0; bj < 2; ++bj)
#pragma unroll
            for (int n = 0; n < 2; ++n) { const int c = bj * HALF + 4 * n; g1[bj][n] = *(const f32x4*)(gate + col0 + c) * *(const f32x4*)(gpost + col0 + c); }
        f32x4 pre[2][2][2];
#pragma unroll
        for (int m = 0; m < 2; ++m) { const size_t off = (size_t)(u.pm * BM + wr * 64 + m * 16 + fr) * 1024 + col0;
#pragma unroll
            for (int bj = 0; bj < 2; ++bj) load8(off + bj * HALF, pre[m][bj][0], pre[m][bj][1]); }
        st1.run(acc, u, wr, wc, fr, fq, ldsx, wid, lane);
#pragma unroll
        for (int ai = 0; ai < 2; ++ai)
#pragma unroll
            for (int m = 0; m < 4; ++m) { const int r = ai * HALF + wr * 64 + m * 16 + fr; const float rs = __builtin_amdgcn_rsqf(S[r] * (1.f / 1024.f) + EPS); const size_t off = (size_t)(u.pm * BM + r) * 1024 + col0;
#pragma unroll
                for (int bj = 0; bj < 2; ++bj) { f32x4 xv0, xv1;
                    if (ai == 0 && m < 2) { xv0 = pre[m & 1][bj][0]; xv1 = pre[m & 1][bj][1]; } else load8(off + bj * HALF, xv0, xv1);
                    const f32x4 x10 = xv0 + g1[bj][0] * (acc[ai][bj][m][0] * rs), x11 = xv1 + g1[bj][1] * (acc[ai][bj][m][1] * rs);
                    store8(off + bj * HALF, x10, x11); acc[ai][bj][m][0] = x10; acc[ai][bj][m][1] = x11; }
                asm volatile("" : "+v"(acc[ai][0][m][0]), "+v"(acc[ai][0][m][1]), "+v"(acc[ai][1][m][0]), "+v"(acc[ai][1][m][1]));
                if (m & 1) asm volatile("" ::: "memory"); }
        if (do_next) {
            f32x4 a2[2][2], b2[2][2];
#pragma unroll
            for (int bj = 0; bj < 2; ++bj)
#pragma unroll
                for (int n = 0; n < 2; ++n) { const int c = bj * HALF + 4 * n; a2[bj][n] = *(const f32x4*)(gn + col0 + c) * (*(const f32x4*)(scn + col0 + c) + 1.f); b2[bj][n] = *(const f32x4*)(shn + col0 + c); }
            st2.run(acc, u, wr, wc, fr, fq, ldsx, wid, lane);
#pragma unroll
            for (int ai = 0; ai < 2; ++ai)
#pragma unroll
                for (int m = 0; m < 4; ++m) { const int r = ai * HALF + wr * 64 + m * 16 + fr; const float rs = __builtin_amdgcn_rsqf(S[r] * (1.f / 1024.f) + EPS); const size_t off = (size_t)(u.pm * BM + r) * 1024 + col0;
#pragma unroll
                    for (int bj = 0; bj < 2; ++bj) { const f32x4 h0 = acc[ai][bj][m][0] * rs * a2[bj][0] + b2[bj][0], h1 = acc[ai][bj][m][1] * rs * a2[bj][1] + b2[bj][1];
                        u32x4 w; w.x = pk2(h0[0], h0[1]); w.y = pk2(h0[2], h0[3]); w.z = pk2(h1[0], h1[1]); w.w = pk2(h1[2], h1[3]);
                        *(u32x4*)(hout + off + bj * HALF) = w; } }
        }
    }
};

template <class Epi>
__device__ __forceinline__ void gemm_phase(LAS unsigned char* lds, const Gemm g, const StaticOrder& S, const Epi& E) {
    int tid = threadIdx.x; asm volatile("" : "+v"(tid));
    const int wid = __builtin_amdgcn_readfirstlane(tid >> 6), lane = tid & 63, wr = wid >> 2, wc = wid & 3, fr = lane & 15, fq = lane >> 4;
    const int K = g.K, nt = K / BK;
    unsigned voffA[2], voffB[2];
#pragma unroll
    for (int i = 0; i < 2; ++i) { int R, C; stage_rc(tid * 16 + i * 8192, R, C); const int Rb = (R & ~31) + perm32(R & 31);
        voffA[i] = (unsigned)(R * g.lda + C) * 2u; voffB[i] = (unsigned)(Rb * g.ldb + C) * 2u; }
    const size_t kstep = (size_t)(BK * 2);
    const size_t hstepA = (size_t)HALF * g.lda * 2, hstepB = (size_t)HALF * g.ldb * 2;
    const size_t tstepA = 2 * hstepA, tstepB = 2 * hstepB;
    const unsigned ldsw = (unsigned)wid * 1024u;
    const int aoff = lds_byte(wr * 64 + fr, fq * 8), boff = lds_byte(wc * 32 + fr, fq * 8);
#define PG8_SA(b, h) (((b) * 2 + (h)) * HTB)
#define PG8_SB(b, h) ((4 + (b) * 2 + (h)) * HTB)
#define PG8_STAGE(bufoff, gbase, voff) do { _Pragma("unroll") for (int _i = 0; _i < 2; ++_i) \
        __builtin_amdgcn_global_load_lds((const unsigned*)((const char*)(gbase) + (voff)[_i]), (LAS unsigned*)(lds + (bufoff) + ldsw + _i * 8192), 16, 0, 0); } while (0)
#define PG8_LDA(dst, b, h) do { _Pragma("unroll") for (int m = 0; m < 4; ++m) _Pragma("unroll") for (int k = 0; k < 2; ++k) dst[m][k] = *(const LAS bf16x8*)(lds + PG8_SA(b, h) + aoff + m * 2048 + k * 1024); } while (0)
#define PG8_LDB(dst, b, h) do { _Pragma("unroll") for (int n = 0; n < 2; ++n) _Pragma("unroll") for (int k = 0; k < 2; ++k) dst[n][k] = *(const LAS bf16x8*)(lds + PG8_SB(b, h) + boff + n * 2048 + k * 1024); } while (0)
#define PG8_MMA(ai, bj, At, Bt) do { __builtin_amdgcn_s_setprio(1); _Pragma("unroll") for (int m = 0; m < 4; ++m) _Pragma("unroll") for (int n = 0; n < 2; ++n) _Pragma("unroll") for (int k = 0; k < 2; ++k) \
        acc[ai][bj][m][n] = __builtin_amdgcn_mfma_f32_16x16x32_bf16(Bt[n][k], At[m][k], acc[ai][bj][m][n], 0, 0, 0); __builtin_amdgcn_s_setprio(0); } while (0)
#define PG8_WAIT_V(n) asm volatile("s_waitcnt vmcnt(" #n ")" ::: "memory")
#define PG8_WAIT_L(n) asm volatile("s_waitcnt lgkmcnt(" #n ")" ::: "memory")
#define PG8_BAR __builtin_amdgcn_s_barrier()
#define PG8_SCHED __builtin_amdgcn_sched_barrier(0)
    Unit cur, nxt; int ui = 0;
    if (!S.next(0, cur)) return;
    f32x4 acc[2][2][4][2];
#pragma unroll
    for (int a = 0; a < 2; ++a)
#pragma unroll
        for (int b = 0; b < 2; ++b)
#pragma unroll
            for (int m = 0; m < 4; ++m)
#pragma unroll
                for (int n = 0; n < 2; ++n) acc[a][b][m][n] = (f32x4){0.f, 0.f, 0.f, 0.f};
    bf16x8 At[4][2], B0[2][2], B1[2][2];
    const char* cA = (const char*)g.A + (size_t)cur.pm * tstepA; const char* cB = (const char*)g.Bt + (size_t)cur.pn * tstepB;
    PG8_STAGE(PG8_SB(0, 0), cB, voffB); PG8_STAGE(PG8_SB(0, 1), cB + hstepB, voffB); PG8_STAGE(PG8_SA(0, 0), cA, voffA); PG8_STAGE(PG8_SA(0, 1), cA + hstepA, voffA);
    if (wr == 1) PG8_BAR;
    PG8_WAIT_V(2); PG8_BAR;
    PG8_STAGE(PG8_SB(1, 0), cB + kstep, voffB); PG8_STAGE(PG8_SA(1, 0), cA + kstep, voffA); PG8_STAGE(PG8_SB(1, 1), cB + hstepB + kstep, voffB);
    PG8_WAIT_V(6); PG8_BAR;
    for (;;) {
        const bool has_next = S.next(ui + 1, nxt);
        const char* nA = has_next ? (const char*)g.A + (size_t)nxt.pm * tstepA : cA; const char* nB = has_next ? (const char*)g.Bt + (size_t)nxt.pn * tstepB : cB;
#pragma unroll 1
        for (int t = 0; t < nt; t += 2) {
            if constexpr (Epi::HOOK) { if (t == 4 || t == 8) E.hook(acc, cur, t, wr, wc, fr, fq); }
            const bool last = (t == nt - 2);
            const char* a1 = cA + (size_t)(t + 1) * kstep;
            const char* a2 = last ? nA : cA + (size_t)(t + 2) * kstep; const char* b2 = last ? nB : cB + (size_t)(t + 2) * kstep;
            const char* a3 = a2 + kstep; const char* b3 = b2 + kstep;
            PG8_LDB(B0, 0, 0); PG8_LDB(B1, 0, 1); PG8_SCHED; PG8_LDA(At, 0, 0); PG8_STAGE(PG8_SA(1, 1), a1 + hstepA, voffA);
            PG8_WAIT_V(8); PG8_WAIT_L(0); PG8_BAR; PG8_MMA(0, 0, At, B0); PG8_MMA(0, 1, At, B1); PG8_BAR; PG8_SCHED;
            PG8_LDA(At, 0, 1); PG8_STAGE(PG8_SB(0, 0), b2, voffB); PG8_STAGE(PG8_SB(0, 1), b2 + hstepB, voffB); PG8_STAGE(PG8_SA(0, 0), a2, voffA);
            PG8_WAIT_V(8); PG8_WAIT_L(0); PG8_BAR; PG8_MMA(1, 0, At, B0); PG8_MMA(1, 1, At, B1); PG8_BAR; PG8_SCHED;
            PG8_LDB(B0, 1, 0); PG8_LDB(B1, 1, 1); PG8_SCHED; PG8_LDA(At, 1, 0); PG8_STAGE(PG8_SA(0, 1), a2 + hstepA, voffA);
            PG8_WAIT_V(8); PG8_WAIT_L(0); PG8_BAR; PG8_MMA(0, 0, At, B0); PG8_MMA(0, 1, At, B1); PG8_BAR; PG8_SCHED;
            PG8_LDA(At, 1, 1); PG8_STAGE(PG8_SB(1, 0), b3, voffB); PG8_STAGE(PG8_SB(1, 1), b3 + hstepB, voffB); PG8_STAGE(PG8_SA(1, 0), a3, voffA);
            PG8_WAIT_V(8); PG8_WAIT_L(0); PG8_BAR; PG8_MMA(1, 0, At, B0); PG8_MMA(1, 1, At, B1); PG8_BAR; PG8_SCHED;
        }
        if (wr == 0) PG8_BAR;
        if constexpr (Epi::FUSED) E.fused(acc, cur, wr, wc, fr, fq, lds + STAGE_BYTES, wid, lane); else E(acc, cur, wr, wc, fr, fq);
        if (!has_next) break;
#pragma unroll
        for (int a = 0; a < 2; ++a)
#pragma unroll
            for (int b = 0; b < 2; ++b)
#pragma unroll
                for (int m = 0; m < 4; ++m)
#pragma unroll
                    for (int n = 0; n < 2; ++n) acc[a][b][m][n] = (f32x4){0.f, 0.f, 0.f, 0.f};
        cur = nxt; cA = nA; cB = nB; ++ui;
        if (wr == 1) PG8_BAR;
    }
    PG8_WAIT_V(0);
    PG8_BAR;
#undef PG8_SA
#undef PG8_SB
#undef PG8_STAGE
#undef PG8_LDA
#undef PG8_LDB
#undef PG8_MMA
#undef PG8_WAIT_V
#undef PG8_WAIT_L
#undef PG8_BAR
#undef PG8_SCHED
}
}

constexpr int NWAVES = 8, NTHREADS = 512;
constexpr int LDS_BYTES = 147456;

__device__ __forceinline__ void tr_item(const float* W, int ldw, int src_col0, int nvalid, int k0, bf16_t* WT, int ldwt, int dst_row0, int dst_col0, LAS float* scr, int lane) {
    const int kr = lane >> 3, jq = lane & 7;
    f32x4 v[8];
#pragma unroll
    for (int i = 0; i < 8; ++i) { v[i] = (f32x4){0.f, 0.f, 0.f, 0.f}; if (4 * jq < nvalid) v[i] = *(const f32x4*)(W + (size_t)(k0 + 8 * i + kr) * ldw + src_col0 + 4 * jq); }
#pragma unroll
    for (int i = 0; i < 8; ++i) { LAS float* d = scr + (8 * i + kr) * 33 + 4 * jq; d[0] = v[i][0]; d[1] = v[i][1]; d[2] = v[i][2]; d[3] = v[i][3]; }
    LDS_WAIT();
    const int c = lane & 7;
#pragma unroll
    for (int q = 0; q < 4; ++q) { const int n = (lane >> 3) + 8 * q; const LAS float* s = scr + (8 * c) * 33 + n;
        u32x4 o; o.x = pk2(s[0 * 33], s[1 * 33]); o.y = pk2(s[2 * 33], s[3 * 33]); o.z = pk2(s[4 * 33], s[5 * 33]); o.w = pk2(s[6 * 33], s[7 * 33]);
        *(u32x4*)(WT + (size_t)(dst_row0 + n) * ldwt + dst_col0 + k0 + 8 * c) = o; }
    LDS_WAIT();
}
__device__ __forceinline__ void win_map(int d0, int& src, int& nvalid) {
    nvalid = 32;
    if (d0 < 256) src = d0;
    else if (d0 < 512) src = 768 + (d0 - 256);
    else if (d0 < 1024) src = 1536 + (d0 - 512);
    else if (d0 < 1280) src = 256 + (d0 - 1024);
    else if (d0 < 1536) src = 512 + (d0 - 1280);
    else if (d0 < 1792) src = 1024 + (d0 - 1536);
    else if (d0 < 2048) src = 1280 + (d0 - 1792);
    else if (d0 < 2816) src = d0;
    else if (d0 < 5888) src = d0 + 8;
    else if (d0 == 5888) { src = 2816; nvalid = 8; }
    else { src = 0; nvalid = 0; }
}
constexpr int TR_PER_LAYER = 3072 + 128 + 128 + 256 + 512 + 2816 + 1408;
__device__ __forceinline__ void tr_dispatch(KA a, int it, LAS float* scr, int lane) {
    const int l = it / TR_PER_LAYER; int r = it % TR_PER_LAYER;
    unsigned char* wl = a->ws + WS_W + (size_t)l * W_LAYER;
    if (r < 3072) { const int kb = r / 192, nb = r % 192, d0 = nb * 32; int src, nv; win_map(d0, src, nv);
        tr_item(a->in[IN_WIN] + (size_t)l * D * NSRC, NSRC, src, nv, kb * 64, (bf16_t*)(wl + W_IN), D, d0, 0, scr, lane); return; }
    r -= 3072;
    if (r < 128) { const int kb = r / 32, nb = r % 32; tr_item(a->in[IN_WSC] + (size_t)l * 256 * D, D, nb * 32, 32, kb * 64, (bf16_t*)(wl + W_OUT3), D, nb * 32, 0, scr, lane); return; }
    r -= 128;
    if (r < 128) { const int kb = r / 32, nb = r % 32; tr_item(a->in[IN_WSB] + (size_t)l * 256 * D, D, nb * 32, 32, kb * 64, (bf16_t*)(wl + W_OUT3), D, nb * 32, 256, scr, lane); return; }
    r -= 128;
    if (r < 256) { const int kb = r / 32, nb = r % 32; tr_item(a->in[IN_WSSM] + (size_t)l * 512 * D, D, nb * 32, 32, kb * 64, (bf16_t*)(wl + W_OUT3), D, nb * 32, 512, scr, lane); return; }
    r -= 256;
    if (r < 512) { const int kb = r / 32, nb = r % 32; tr_item(a->in[IN_WO] + (size_t)l * D * D, D, nb * 32, 32, kb * 64, (bf16_t*)(wl + W_O), D, nb * 32, 0, scr, lane); return; }
    r -= 512;
    if (r < 2816) { const int kb = r / 176, nb = r % 176, d0 = nb * 32, pn = d0 >> 8, within = d0 & 255, half = within >> 7, i = within & 127;
        tr_item(a->in[IN_WFI] + (size_t)l * D * 2 * FFN, 2 * FFN, half * FFN + pn * 128 + i, 32, kb * 64, (bf16_t*)(wl + W_FI), D, d0, 0, scr, lane); return; }
    r -= 2816;
    { const int kb = r / 32, nb = r % 32; tr_item(a->in[IN_WFO] + (size_t)l * FFN * D, D, nb * 32, 32, kb * 64, (bf16_t*)(wl + W_FO), FFN, nb * 32, 0, scr, lane); }
}
__device__ __forceinline__ void mod_item(KA a, int item, LAS float* red, int tid) {
    const int l = item / 96, nb = item % 96, n0 = nb * 64, j4 = tid & 15, ks = tid >> 4;
    const float* w = a->in[IN_MODW] + (size_t)l * D * 6144 + n0 + 4 * j4; const float* c = a->in[IN_C];
    f32x4 a0 = {0.f, 0.f, 0.f, 0.f}, a1 = {0.f, 0.f, 0.f, 0.f};
#pragma unroll 16
    for (int k = ks * 32; k < ks * 32 + 32; ++k) { const f32x4 wv = *(const f32x4*)(w + (size_t)k * 6144); a0 += wv * siluf_(c[k]); a1 += wv * siluf_(c[D + k]); }
    *(LAS f32x4*)(red + (ks * 2 + 0) * 64 + 4 * j4) = a0; *(LAS f32x4*)(red + (ks * 2 + 1) * 64 + 4 * j4) = a1;
    __syncthreads();
    if (tid < 128) { const int b = tid >> 6, j = tid & 63; float s = 0.f;
#pragma unroll
        for (int q = 0; q < 32; ++q) s += red[(q * 2 + b) * 64 + j];
        ((float*)(a->ws + WS_MOD))[(size_t)(l * 2 + b) * 6144 + n0 + j] = s + a->in[IN_MODB][(size_t)l * 6144 + n0 + j]; }
    __syncthreads();
}

__device__ __forceinline__ void prenorm_row(const float* xrow, const float* g, const float* scale, const float* shift, bf16_t* hrow, int lane) {
    f32x4 v[4]; float ss = 0.f;
#pragma unroll
    for (int j = 0; j < 4; ++j) { v[j] = *(const f32x4*)(xrow + 4 * lane + 256 * j); ss += (v[j][0] * v[j][0] + v[j][1] * v[j][1]) + (v[j][2] * v[j][2] + v[j][3] * v[j][3]); }
    const float rs = 1.0f / sqrtf(wave_sum(ss) * (1.f / D) + EPS);
#pragma unroll
    for (int j = 0; j < 4; ++j) { const int col = 4 * lane + 256 * j;
        const f32x4 gg = *(const f32x4*)(g + col), sc = *(const f32x4*)(scale + col), sh = *(const f32x4*)(shift + col);
        const f32x4 h = v[j] * rs * gg * (sc + 1.f) + sh;
        u32x2 w; w.x = pk2(h[0], h[1]); w.y = pk2(h[2], h[3]); *(u32x2*)(hrow + col) = w; }
}
__device__ __forceinline__ void shortconv_phase(KA a, int l, bf16_t* P, int tid, int vb, int nb) {
    const float* scw = a->in[IN_SCW] + (size_t)l * 3 * 256;
    for (int it = vb * NTHREADS + tid; it < (M / 8) * 32; it += nb * NTHREADS) {
        const int cg8 = it & 31, rb = it >> 5, row0 = rb * 8, tseq = row0 & (SEQ - 1), ch0 = cg8 * 8;
        float w0[8], w1[8], w2[8], c1[8], c2[8];
#pragma unroll
        for (int i = 0; i < 8; ++i) { w0[i] = scw[ch0 + i]; w1[i] = scw[256 + ch0 + i]; w2[i] = scw[512 + ch0 + i]; c1[i] = 0.f; c2[i] = 0.f; }
        if (tseq != 0) {
            const bf16_t* r2 = P + Q_OFF + (size_t)(row0 - 2) * QP + ch0; const bf16_t* r1 = P + Q_OFF + (size_t)(row0 - 1) * QP + ch0;
            const u32x4 cc2 = *(const u32x4*)(r2 + QC_SCC), xx2 = *(const u32x4*)(r2 + QC_SCX), cc1 = *(const u32x4*)(r1 + QC_SCC), xx1 = *(const u32x4*)(r1 + QC_SCX);
            c2[0] = bflo(cc2.x) * bflo(xx2.x); c2[1] = bfhi(cc2.x) * bfhi(xx2.x); c2[2] = bflo(cc2.y) * bflo(xx2.y); c2[3] = bfhi(cc2.y) * bfhi(xx2.y);
            c2[4] = bflo(cc2.z) * bflo(xx2.z); c2[5] = bfhi(cc2.z) * bfhi(xx2.z); c2[6] = bflo(cc2.w) * bflo(xx2.w); c2[7] = bfhi(cc2.w) * bfhi(xx2.w);
            c1[0] = bflo(cc1.x) * bflo(xx1.x); c1[1] = bfhi(cc1.x) * bfhi(xx1.x); c1[2] = bflo(cc1.y) * bflo(xx1.y); c1[3] = bfhi(cc1.y) * bfhi(xx1.y);
            c1[4] = bflo(cc1.z) * bflo(xx1.z); c1[5] = bfhi(cc1.z) * bfhi(xx1.z); c1[6] = bflo(cc1.w) * bflo(xx1.w); c1[7] = bfhi(cc1.w) * bfhi(xx1.w);
        }
#pragma unroll
        for (int r = 0; r < 8; ++r) {
            bf16_t* yp = P + Y_OFF + (size_t)(row0 + r) * YP + ch0 + YC_A; const bf16_t* qp = P + Q_OFF + (size_t)(row0 + r) * QP + ch0;
            const u32x4 bb = *(const u32x4*)yp, cc = *(const u32x4*)(qp + QC_SCC), xx = *(const u32x4*)(qp + QC_SCX);
            float c0[8], bv[8], y[8];
            c0[0] = bflo(cc.x) * bflo(xx.x); c0[1] = bfhi(cc.x) * bfhi(xx.x); c0[2] = bflo(cc.y) * bflo(xx.y); c0[3] = bfhi(cc.y) * bfhi(xx.y);
            c0[4] = bflo(cc.z) * bflo(xx.z); c0[5] = bfhi(cc.z) * bfhi(xx.z); c0[6] = bflo(cc.w) * bflo(xx.w); c0[7] = bfhi(cc.w) * bfhi(xx.w);
            bv[0] = bflo(bb.x); bv[1] = bfhi(bb.x); bv[2] = bflo(bb.y); bv[3] = bfhi(bb.y); bv[4] = bflo(bb.z); bv[5] = bfhi(bb.z); bv[6] = bflo(bb.w); bv[7] = bfhi(bb.w);
#pragma unroll
            for (int i = 0; i < 8; ++i) { y[i] = bv[i] * (w0[i] * c2[i] + w1[i] * c1[i] + w2[i] * c0[i]); c2[i] = c1[i]; c1[i] = c0[i]; }
            u32x4 w; w.x = pk2(y[0], y[1]); w.y = pk2(y[2], y[3]); w.z = pk2(y[4], y[5]); w.w = pk2(y[6], y[7]);
            *(u32x4*)yp = w;
        }
    }
}


typedef float f32x16 __attribute__((ext_vector_type(16)));

template <bool MASKED>
__device__ __forceinline__ void attn_weights(const f32x16 (&st)[2], int s0, int tq, int h, float& run, unsigned (&wp)[2][8]) {
#pragma unroll
    for (int kt = 1; kt >= 0; --kt) {
        float lkv[16], zz[16], T[4], Tp[4];
#pragma unroll
        for (int i = 0; i < 16; ++i) { const float y = st[kt][i] * 1.4426950408889634f;
            const float sp = fmaxf(y, 0.f) + __builtin_amdgcn_logf(1.f + __builtin_amdgcn_exp2f(-fabsf(y)));
            if (MASKED) { const bool valid = (s0 + 32 * kt + (i & 3) + 8 * (i >> 2) + 4 * h) < tq; lkv[i] = valid ? -sp : 0.f; zz[i] = valid ? y - sp : -INFINITY; }
            else { lkv[i] = -sp; zz[i] = y - sp; } }
#pragma unroll
        for (int gq = 0; gq < 4; ++gq) { T[gq] = (lkv[4 * gq] + lkv[4 * gq + 1]) + (lkv[4 * gq + 2] + lkv[4 * gq + 3]); Tp[gq] = __shfl_xor(T[gq], 32); }
        float later = run;
#pragma unroll
        for (int gq = 3; gq >= 0; --gq) {
            const float r3 = later + (h == 0 ? Tp[gq] : 0.f), r2 = r3 + lkv[4 * gq + 3], r1 = r2 + lkv[4 * gq + 2], r0 = r1 + lkv[4 * gq + 1];
            const float w0 = __builtin_amdgcn_exp2f(zz[4 * gq + 0] + r0), w1 = __builtin_amdgcn_exp2f(zz[4 * gq + 1] + r1), w2 = __builtin_amdgcn_exp2f(zz[4 * gq + 2] + r2), w3 = __builtin_amdgcn_exp2f(zz[4 * gq + 3] + r3);
            wp[kt][2 * gq] = pk2(w0, w1); wp[kt][2 * gq + 1] = pk2(w2, w3);
            later += T[gq] + Tp[gq];
        }
        run = later;
    }
}
__device__ __forceinline__ void attn_mfma_unit(bf16_t* P, int unit, LAS unsigned char* wl, int lane) {
    const int qt = unit & 511, hh = (unit >> 9) & 3, b = unit >> 11;
    bf16_t* Yb = P + Y_OFF + (size_t)b * SEQ * YP; const bf16_t* Qb = P + Q_OFF + (size_t)b * SEQ * QP;
    const int q0 = qt * 32, c = lane & 31, h = lane >> 5, tq = q0 + c;
    bf16x8 qf[4];
    { const bf16_t* qp = Yb + (size_t)tq * YP + YC_B + hh * 64 + 8 * h;
#pragma unroll
      for (int ks = 0; ks < 4; ++ks) { const u32x4 w = *(const u32x4*)(qp + 16 * ks); u32x4 o;
          o.x = pk2(bflo(w.x) * 0.125f, bfhi(w.x) * 0.125f); o.y = pk2(bflo(w.y) * 0.125f, bfhi(w.y) * 0.125f);
          o.z = pk2(bflo(w.z) * 0.125f, bfhi(w.z) * 0.125f); o.w = pk2(bflo(w.w) * 0.125f, bfhi(w.w) * 0.125f);
          qf[ks] = __builtin_bit_cast(bf16x8, o); } }
    f32x16 zacc[2];
#pragma unroll
    for (int i = 0; i < 16; ++i) { zacc[0][i] = 0.f; zacc[1][i] = 0.f; }
    float R = 0.f;
    for (int kb = q0 >> 6; kb >= 0; --kb) {
        const int s0 = kb * 64;
        u32x4 vv[8];
        { const u32x4* vrow = (const u32x4*)(Qb + (size_t)(s0 + lane) * QP + QC_V + hh * 64);
#pragma unroll
          for (int i = 0; i < 8; ++i) vv[i] = vrow[i]; }
        bf16x8 kf[2][4];
        { const bf16_t* kp = Qb + (size_t)(s0 + c) * QP + QC_K + hh * 64 + 8 * h;
#pragma unroll
          for (int kt = 0; kt < 2; ++kt)
#pragma unroll
              for (int ks = 0; ks < 4; ++ks) kf[kt][ks] = *(const bf16x8*)(kp + (size_t)32 * kt * QP + 16 * ks); }
        f32x16 st[2];
#pragma unroll
        for (int kt = 0; kt < 2; ++kt) {
#pragma unroll
            for (int i = 0; i < 16; ++i) st[kt][i] = 0.f;
#pragma unroll
            for (int ks = 0; ks < 4; ++ks) st[kt] = __builtin_amdgcn_mfma_f32_32x32x16_bf16(kf[kt][ks], qf[ks], st[kt], 0, 0, 0);
        }
#pragma unroll
        for (int i = 0; i < 8; ++i) { const u32x4 w = vv[i]; LAS unsigned char* base = wl + (8 * i) * 136 + lane * 2;
            *(LAS unsigned short*)(base + 0 * 136) = (unsigned short)(w.x & 0xffffu); *(LAS unsigned short*)(base + 1 * 136) = (unsigned short)(w.x >> 16);
            *(LAS unsigned short*)(base + 2 * 136) = (unsigned short)(w.y & 0xffffu); *(LAS unsigned short*)(base + 3 * 136) = (unsigned short)(w.y >> 16);
            *(LAS unsigned short*)(base + 4 * 136) = (unsigned short)(w.z & 0xffffu); *(LAS unsigned short*)(base + 5 * 136) = (unsigned short)(w.z >> 16);
            *(LAS unsigned short*)(base + 6 * 136) = (unsigned short)(w.w & 0xffffu); *(LAS unsigned short*)(base + 7 * 136) = (unsigned short)(w.w >> 16); }
        unsigned wp[2][8];
        float run = R;
        if (kb == (q0 >> 6)) attn_weights<true>(st, s0, tq, h, run, wp); else attn_weights<false>(st, s0, tq, h, run, wp);
        R = run;
        LDS_WAIT();
#pragma unroll
        for (int kt = 0; kt < 2; ++kt)
#pragma unroll
            for (int s2 = 0; s2 < 2; ++s2) {
                u32x4 af; af.x = wp[kt][4 * s2 + 0]; af.y = wp[kt][4 * s2 + 1]; af.z = wp[kt][4 * s2 + 2]; af.w = wp[kt][4 * s2 + 3];
                const bf16x8 afrag = __builtin_bit_cast(bf16x8, af);
#pragma unroll
                for (int dt = 0; dt < 2; ++dt) {
                    const LAS unsigned char* vp = wl + (c + 32 * dt) * 136 + (32 * kt + 16 * s2 + 4 * h) * 2;
                    const u32x2 lo = *(const LAS u32x2*)vp, hi = *(const LAS u32x2*)(vp + 16);
                    u32x4 bfv; bfv.x = lo.x; bfv.y = lo.y; bfv.z = hi.x; bfv.w = hi.y;
                    zacc[dt] = __builtin_amdgcn_mfma_f32_32x32x16_bf16(afrag, __builtin_bit_cast(bf16x8, bfv), zacc[dt], 0, 0, 0);
                }
            }
        LDS_WAIT();
        if (__all(R < -150.1f)) break;
    }
#pragma unroll
    for (int dt = 0; dt < 2; ++dt)
#pragma unroll
        for (int i = 0; i < 16; ++i) Yb[(size_t)(q0 + (i & 3) + 8 * (i >> 2) + 4 * h) * YP + YC_B + hh * 64 + c + 32 * dt] = (bf16_t)f2bf(zacc[dt][i]);
}


constexpr int L_XT = 0, L_BN = 69632, L_CN = 87040, L_BT = 104448, L_ACS = 121856, L_DTV = 123904, L_ATAB = 125952, L_SS = 128000, L_NW = 130048;
template <bool OUT>
__device__ __forceinline__ void ssd2_stage(KA a, int l, const bf16_t* Qb, int b, int t0, LAS unsigned char* lds, int tid) {
    const float* cw = a->in[IN_SSMCW] + (size_t)l * 4 * 768; const float* cbias = a->in[IN_SSMCB] + (size_t)l * 768;
    const int lane = tid & 63, wave = tid >> 6;
    {
        const int ch = tid; const bf16_t* col = Qb + (size_t)t0 * QP + QC_XBC + ch;
        const float w0 = cw[ch], w1 = cw[768 + ch], w2 = cw[1536 + ch], w3 = cw[2304 + ch], bs = cbias[ch];
        float r1 = 0.f, r2 = 0.f, r3 = 0.f;
        if (t0 > 0) { r1 = bf2f(*(col - (size_t)QP)); r2 = bf2f(*(col - (size_t)2 * QP)); r3 = bf2f(*(col - (size_t)3 * QP)); }
        LAS unsigned char* dst = lds + L_XT + ch * 136;
#pragma unroll 4
        for (int s0 = 0; s0 < 64; s0 += 8) {
            bf16_t raw[8]; float v[8];
#pragma unroll
            for (int j = 0; j < 8; ++j) raw[j] = col[(size_t)(s0 + j) * QP];
#pragma unroll
            for (int j = 0; j < 8; ++j) { const float r0 = bf2f(raw[j]); v[j] = siluf_(w0 * r3 + w1 * r2 + w2 * r1 + w3 * r0 + bs); r3 = r2; r2 = r1; r1 = r0; }
            u32x2 o0, o1; o0.x = pk2(v[0], v[1]); o0.y = pk2(v[2], v[3]); o1.x = pk2(v[4], v[5]); o1.y = pk2(v[6], v[7]);
            *(LAS u32x2*)(dst + s0 * 2) = o0; *(LAS u32x2*)(dst + s0 * 2 + 8) = o1;
        }
    }
    {
        constexpr int NCH = OUT ? 256 : 128, PARTS = NTHREADS / NCH, RPP = 64 / PARTS;
        const int ch2 = tid % NCH, rs = (tid / NCH) * RPP;
        const bf16_t* col = Qb + (size_t)(t0 + rs) * QP + QC_XBC + 512 + ch2;
        const float w0 = cw[512 + ch2], w1 = cw[768 + 512 + ch2], w2 = cw[1536 + 512 + ch2], w3 = cw[2304 + 512 + ch2], bs = cbias[512 + ch2];
        float r1 = 0.f, r2 = 0.f, r3 = 0.f;
        if (t0 + rs > 0) { r1 = bf2f(*(col - (size_t)QP)); r2 = bf2f(*(col - (size_t)2 * QP)); r3 = bf2f(*(col - (size_t)3 * QP)); }
        const bool isB = ch2 < 128;
        LAS unsigned char* nat = lds + (isB ? L_BN + ch2 * 2 : L_CN + (ch2 - 128) * 2) + rs * 272;
        LAS unsigned char* tr = lds + L_BT + ch2 * 136 + rs * 2;
#pragma unroll
        for (int s0 = 0; s0 < RPP; s0 += 8) {
            bf16_t raw[8]; float v[8];
#pragma unroll
            for (int j = 0; j < 8; ++j) raw[j] = col[(size_t)(s0 + j) * QP];
#pragma unroll
            for (int j = 0; j < 8; ++j) { const float r0 = bf2f(raw[j]); v[j] = siluf_(w0 * r3 + w1 * r2 + w2 * r1 + w3 * r0 + bs); r3 = r2; r2 = r1; r1 = r0; }
            if (OUT) {
#pragma unroll
                for (int j = 0; j < 8; ++j) *(LAS unsigned short*)(nat + (s0 + j) * 272) = (unsigned short)f2bf(v[j]);
            } else {
                u32x2 o0, o1; o0.x = pk2(v[0], v[1]); o0.y = pk2(v[2], v[3]); o1.x = pk2(v[4], v[5]); o1.y = pk2(v[6], v[7]);
                *(LAS u32x2*)(tr + s0 * 2) = o0; *(LAS u32x2*)(tr + s0 * 2 + 8) = o1;
            }
        }
    }
    {
        const int r = tid >> 3, hh = tid & 7;
        const float dtr = ((const float*)(a->ws + WS_DT))[(size_t)(b * SEQ + t0 + r) * 8 + hh] + a->in[IN_DTB][l * 8 + hh];
        const float dtv = softplusf_(dtr);
        ((LAS float*)(lds + L_DTV))[r * 8 + hh] = dtv; ((LAS float*)(lds + L_ATAB))[hh * 64 + r] = -dtv * __expf(a->in[IN_ALOG][l * 8 + hh]);
    }
    if (OUT) ((LAS float*)(lds + L_NW))[tid] = a->in[IN_SSMNW][(size_t)l * 512 + tid];
    __syncthreads();
    {
        float v = ((LAS float*)(lds + L_ATAB))[wave * 64 + lane];
#pragma unroll
        for (int o = 1; o < 64; o <<= 1) { const float u = __shfl_up(v, o); if (lane >= o) v += u; }
        ((LAS float*)(lds + L_ACS))[lane * 8 + wave] = v;
    }
    __syncthreads();
}
__device__ __forceinline__ bf16x8 rd2x64(const LAS unsigned char* p) { const u32x2 lo = *(const LAS u32x2*)p, hi = *(const LAS u32x2*)(p + 8); u32x4 v; v.x = lo.x; v.y = lo.y; v.z = hi.x; v.w = hi.y; return __builtin_bit_cast(bf16x8, v); }
__device__ __forceinline__ bf16x8 rd2x64_gap(const LAS unsigned char* p) { const u32x2 lo = *(const LAS u32x2*)p, hi = *(const LAS u32x2*)(p + 16); u32x4 v; v.x = lo.x; v.y = lo.y; v.z = hi.x; v.w = hi.y; return __builtin_bit_cast(bf16x8, v); }

__device__ __forceinline__ void ssd2_pass1(KA a, int l, bf16_t* P, int unit, LAS unsigned char* lds, int tid) {
    const int b = unit / SSD_NCH, ck = unit % SSD_NCH, t0 = ck * SSD_CH;
    const bf16_t* Qb = P + Q_OFF + (size_t)b * SEQ * QP;
    ssd2_stage<false>(a, l, Qb, b, t0, lds, tid);
    const int lane = tid & 63, h = __builtin_amdgcn_readfirstlane(tid >> 6), g = h >> 2, c = lane & 31, hh = lane >> 5;
    const LAS float* ACS = (const LAS float*)(lds + L_ACS); const LAS float* DTV = (const LAS float*)(lds + L_DTV);
    const float acs_end = ACS[63 * 8 + h];
    f32x16 sacc[2][2];
#pragma unroll
    for (int i = 0; i < 16; ++i) { sacc[0][0][i] = 0.f; sacc[0][1][i] = 0.f; sacc[1][0][i] = 0.f; sacc[1][1][i] = 0.f; }
#pragma unroll
    for (int ks = 0; ks < 4; ++ks) {
        float wg[8];
#pragma unroll
        for (int j = 0; j < 8; ++j) { const int s = 16 * ks + 8 * hh + j; wg[j] = DTV[s * 8 + h] * __expf(acs_end - ACS[s * 8 + h]); }
        bf16x8 bfr[2];
#pragma unroll
        for (int nt = 0; nt < 2; ++nt) bfr[nt] = rd2x64(lds + L_BT + (g * 64 + c + 32 * nt) * 136 + (16 * ks + 8 * hh) * 2);
#pragma unroll
        for (int pt = 0; pt < 2; ++pt) {
            const LAS unsigned char* xp = lds + L_XT + (h * 64 + c + 32 * pt) * 136 + (16 * ks + 8 * hh) * 2;
            const u32x2 lo = *(const LAS u32x2*)xp, hi = *(const LAS u32x2*)(xp + 8);
            u32x4 o; o.x = pk2(bflo(lo.x) * wg[0], bfhi(lo.x) * wg[1]); o.y = pk2(bflo(lo.y) * wg[2], bfhi(lo.y) * wg[3]);
            o.z = pk2(bflo(hi.x) * wg[4], bfhi(hi.x) * wg[5]); o.w = pk2(bflo(hi.y) * wg[6], bfhi(hi.y) * wg[7]);
            const bf16x8 afr = __builtin_bit_cast(bf16x8, o);
#pragma unroll
            for (int nt = 0; nt < 2; ++nt) sacc[pt][nt] = __builtin_amdgcn_mfma_f32_32x32x16_bf16(afr, bfr[nt], sacc[pt][nt], 0, 0, 0);
        }
    }
    bf16_t* stp = (bf16_t*)(a->ws + WS_HM) + ((size_t)(b * SSD_NCH + ck) * 8 + h) * 4096;
#pragma unroll
    for (int pt = 0; pt < 2; ++pt)
#pragma unroll
        for (int nt = 0; nt < 2; ++nt)
#pragma unroll
            for (int i = 0; i < 16; ++i) stp[(32 * pt + (i & 3) + 8 * (i >> 2) + 4 * hh) * 64 + c + 32 * nt] = (bf16_t)f2bf(sacc[pt][nt][i]);
    if (lane == 0) ((float*)(a->ws + WS_CD))[(size_t)(b * SSD_NCH + ck) * 8 + h] = acs_end;
    __syncthreads();
}

__device__ __forceinline__ void ssd2_pass3(KA a, int l, bf16_t* P, int unit, LAS unsigned char* lds, int tid) {
    const int b = unit / SSD_NCH, ck = unit % SSD_NCH, t0 = ck * SSD_CH;
    bf16_t* Yb = P + Y_OFF + (size_t)b * SEQ * YP; const bf16_t* Qb = P + Q_OFF + (size_t)b * SEQ * QP;
    ssd2_stage<true>(a, l, Qb, b, t0, lds, tid);
    const int lane = tid & 63, h = __builtin_amdgcn_readfirstlane(tid >> 6), g = h >> 2, c = lane & 31, hh = lane >> 5;
    const LAS float* ACS = (const LAS float*)(lds + L_ACS); const LAS float* DTV = (const LAS float*)(lds + L_DTV);
    LAS float* SS = (LAS float*)(lds + L_SS); const LAS float* NW = (const LAS float*)(lds + L_NW);
    f32x16 acc[2][2];
    const float Dh = a->in[IN_SSMD][l * 8 + h];
    const bf16_t* prev = (const bf16_t*)(a->ws + WS_HM) + ((size_t)(b * SSD_NCH + ck) * 8 + h) * 4096;
#pragma unroll
    for (int tt = 0; tt < 2; ++tt) {
        asm volatile("" ::: "memory"); __builtin_amdgcn_sched_barrier(0);
        const int t = c + 32 * tt;
        const float acs_t = ACS[t * 8 + h];
        bf16x8 cfr[4];
#pragma unroll
        for (int ks = 0; ks < 4; ++ks) cfr[ks] = *(const LAS bf16x8*)(lds + L_CN + t * 272 + (g * 64 + 16 * ks + 8 * hh) * 2);
#pragma unroll
        for (int i = 0; i < 16; ++i) { acc[0][tt][i] = 0.f; acc[1][tt][i] = 0.f; }
#pragma unroll
        for (int st = 0; st <= tt; ++st) {
            f32x16 gm;
#pragma unroll
            for (int i = 0; i < 16; ++i) gm[i] = 0.f;
#pragma unroll
            for (int ks = 0; ks < 4; ++ks) {
                const bf16x8 bfr = *(const LAS bf16x8*)(lds + L_BN + (c + 32 * st) * 272 + (g * 64 + 16 * ks + 8 * hh) * 2);
                gm = __builtin_amdgcn_mfma_f32_32x32x16_bf16(bfr, cfr[ks], gm, 0, 0, 0);
            }
            unsigned wp[8];
#pragma unroll
            for (int i2 = 0; i2 < 8; ++i2) {
                float w2[2];
#pragma unroll
                for (int e = 0; e < 2; ++e) { const int i = 2 * i2 + e; const int sx = 32 * st + (i & 3) + 8 * (i >> 2) + 4 * hh;
                    const float v = gm[i] * __expf(acs_t - ACS[sx * 8 + h]) * DTV[sx * 8 + h];
                    w2[e] = (sx <= t) ? v : 0.f; }
                wp[i2] = pk2(w2[0], w2[1]);
            }
#pragma unroll
            for (int s2 = 0; s2 < 2; ++s2) {
                u32x4 wv; wv.x = wp[4 * s2]; wv.y = wp[4 * s2 + 1]; wv.z = wp[4 * s2 + 2]; wv.w = wp[4 * s2 + 3];
                const bf16x8 wfr = __builtin_bit_cast(bf16x8, wv);
#pragma unroll
                for (int pt = 0; pt < 2; ++pt) {
                    const bf16x8 xfr = rd2x64_gap(lds + L_XT + (h * 64 + c + 32 * pt) * 136 + (32 * st + 16 * s2 + 4 * hh) * 2);
                    acc[pt][tt] = __builtin_amdgcn_mfma_f32_32x32x16_bf16(xfr, wfr, acc[pt][tt], 0, 0, 0);
                }
            }
        }
        {
            const float et = __expf(acs_t);
#pragma unroll
            for (int ks = 0; ks < 4; ++ks) {
                const u32x4 cv = __builtin_bit_cast(u32x4, cfr[ks]); u32x4 o;
                o.x = pk2(bflo(cv.x) * et, bfhi(cv.x) * et); o.y = pk2(bflo(cv.y) * et, bfhi(cv.y) * et); o.z = pk2(bflo(cv.z) * et, bfhi(cv.z) * et); o.w = pk2(bflo(cv.w) * et, bfhi(cv.w) * et);
                const bf16x8 cs = __builtin_bit_cast(bf16x8, o);
#pragma unroll
                for (int pt = 0; pt < 2; ++pt) {
                    const bf16x8 pfr = *(const bf16x8*)(prev + (c + 32 * pt) * 64 + 16 * ks + 8 * hh);
                    acc[pt][tt] = __builtin_amdgcn_mfma_f32_32x32x16_bf16(pfr, cs, acc[pt][tt], 0, 0, 0);
                }
            }
        }
        const u32x4* zrow = (const u32x4*)(Yb + (size_t)(t0 + t) * YP + YC_C + h * 64);
        float ss = 0.f;
#pragma unroll
        for (int pt = 0; pt < 2; ++pt)
#pragma unroll
            for (int q = 0; q < 4; ++q) {
                const u32x4 zr = zrow[4 * pt + q];
                const unsigned zlo = hh ? zr.z : zr.x, zhi = hh ? zr.w : zr.y;
                const float zv[4] = {bflo(zlo), bfhi(zlo), bflo(zhi), bfhi(zhi)};
#pragma unroll
                for (int r = 0; r < 4; ++r) { const int i = 4 * q + r, p = 32 * pt + 8 * q + 4 * hh + r;
                    const float xv = bf2f(*(const LAS unsigned short*)(lds + L_XT + (h * 64 + p) * 136 + t * 2));
                    const float yz = (acc[pt][tt][i] + Dh * xv) * siluf_(zv[r]);
                    acc[pt][tt][i] = yz; ss += yz * yz; }
            }
        ss += __shfl_xor(ss, 32);
        if (hh == 0) SS[t * 8 + h] = ss;
    }
    __syncthreads();
#pragma unroll
    for (int tt = 0; tt < 2; ++tt) {
        const int t = c + 32 * tt;
        const float tot = (SS[t * 8 + g * 4 + 0] + SS[t * 8 + g * 4 + 1]) + (SS[t * 8 + g * 4 + 2] + SS[t * 8 + g * 4 + 3]);
        const float rs = 1.0f / sqrtf(tot * (1.f / 256.f) + EPS);
        bf16_t* orow = Yb + (size_t)(t0 + t) * YP + YC_C + h * 64;
#pragma unroll
        for (int pt = 0; pt < 2; ++pt)
#pragma unroll
            for (int q = 0; q < 4; ++q) { const int p0 = 32 * pt + 8 * q + 4 * hh; const f32x4 nw = *(const LAS f32x4*)(NW + h * 64 + p0);
                u32x2 o; o.x = pk2(acc[pt][tt][4 * q + 0] * rs * nw[0], acc[pt][tt][4 * q + 1] * rs * nw[1]); o.y = pk2(acc[pt][tt][4 * q + 2] * rs * nw[2], acc[pt][tt][4 * q + 3] * rs * nw[3]);
                *(u32x2*)(orow + p0) = o; }
    }
    __syncthreads();
}
__device__ __forceinline__ void ssd2_scan_phase(KA a, int tid) {
    bf16_t* STATES = (bf16_t*)(a->ws + WS_HM); const float* CDp = (const float*)(a->ws + WS_CD);
    for (int it = blockIdx.x * NTHREADS + tid; it < BATCH * 8 * 4096; it += gridDim.x * NTHREADS) {
        const int e = it & 4095, bh = it >> 12, b = bh >> 3, h = bh & 7;
        float run = 0.f;
#pragma unroll 32
        for (int cc = 0; cc < SSD_NCH; ++cc) {
            bf16_t* p = STATES + ((size_t)(b * SSD_NCH + cc) * 8 + h) * 4096 + e;
            const float sv = bf2f(*p); const float dec = __expf(CDp[(size_t)(b * SSD_NCH + cc) * 8 + h]);
            *p = (bf16_t)f2bf(run); run = run * dec + sv;
        }
    }
}

#define XB_TMO      128
#define XB_XCNT(j)  (256  + 64 * (j))
#define XB_XSUB(j)  (1280 + 64 * (j))
#define XB_XGEN(j)  (2304 + 64 * (j))
#define XB_TOP      3328
#define XB_TOPGEN   3392
#define XCD_BAR_WORDS 3456
#define XB_SPIN_CAP (1u << 22)
__device__ __forceinline__ unsigned xb_ld(unsigned* p)              { return __hip_atomic_load(p, __ATOMIC_RELAXED, __HIP_MEMORY_SCOPE_AGENT); }
__device__ __forceinline__ unsigned xb_add(unsigned* p, unsigned v) { return __hip_atomic_fetch_add(p, v, __ATOMIC_RELAXED, __HIP_MEMORY_SCOPE_AGENT); }
__device__ __forceinline__ unsigned xb_xcc_id() { return (unsigned)__builtin_amdgcn_s_getreg((3 << 11) | 20) & 0xFu; }
#define XB_SPIN(cond, bar) do { unsigned _sp = 0; while (cond) { __builtin_amdgcn_s_sleep(1); \
    if ((++_sp & 255u) == 0u) { if (xb_ld(&(bar)[XB_TMO])) break; if (_sp > XB_SPIN_CAP) { atomicAdd(&(bar)[XB_TMO], 1u); break; } } } } while (0)
struct XcdBarrier { unsigned* bar; unsigned x; volatile LAS unsigned* st; };
__device__ __forceinline__ XcdBarrier xcd_barrier_post(unsigned* bar, volatile LAS unsigned* st) {
    XcdBarrier b; b.bar = bar; b.x = xb_xcc_id(); b.st = st;
    if (threadIdx.x == 0) (void)xb_add(&bar[XB_XCNT(b.x)], 1u);
    return b;
}
__device__ __forceinline__ void xcd_barrier_complete(unsigned* bar, unsigned x, unsigned& nloc, unsigned& nx) {
    const unsigned G = gridDim.x * gridDim.y * gridDim.z;
    unsigned sum, cnt, mine, sp = 0u;
    for (;;) {
        sum = 0u; cnt = 0u; mine = 0u;
#pragma unroll 1
        for (unsigned j = 0; j < 16; ++j) { const unsigned c = xb_ld(&bar[XB_XCNT(j)]); sum += c; cnt += (c > 0u) ? 1u : 0u; mine = (j == x) ? c : mine; }
        if (sum == G) break;
        __builtin_amdgcn_s_sleep(1);
        if ((++sp & 255u) == 0u) { if (xb_ld(&bar[XB_TMO])) break; if (sp > XB_SPIN_CAP) { atomicAdd(&bar[XB_TMO], 1u); break; } }
    }
    nloc = mine > 0u ? mine : 1u; nx = cnt > 0u ? cnt : 1u;
}
__device__ __forceinline__ void xcd_barrier(const XcdBarrier& b) {
    asm volatile("s_waitcnt vmcnt(0)" ::: "memory");
    __syncthreads();
    if (threadIdx.x == 0) {
        unsigned* bar = b.bar;
        __builtin_amdgcn_s_waitcnt(0);
        unsigned nloc = b.st[0], nx = b.st[1];
        if (nloc == 0u) { xcd_barrier_complete(bar, b.x, nloc, nx); b.st[0] = nloc; b.st[1] = nx; }
        const unsigned old = xb_add(&bar[XB_XSUB(b.x)], 1u);
        const unsigned gen = old / nloc;
        if (old + 1u == (gen + 1u) * nloc) {
            __builtin_amdgcn_fence(__ATOMIC_RELEASE, "agent");
            asm volatile("s_waitcnt vmcnt(0)" ::: "memory");
            const unsigned og = xb_add(&bar[XB_TOP], 1u);
            const unsigned tg = og / nx;
            if (og + 1u == (tg + 1u) * nx) xb_add(&bar[XB_TOPGEN], 1u);
            else XB_SPIN(xb_ld(&bar[XB_TOPGEN]) == tg, bar);
            __builtin_amdgcn_fence(__ATOMIC_ACQUIRE, "agent");
            xb_add(&bar[XB_XGEN(b.x)], 1u);
            asm volatile("s_waitcnt vmcnt(0)" ::: "memory");
        } else {
            XB_SPIN(xb_ld(&bar[XB_XGEN(b.x)]) == gen, bar);
            __builtin_amdgcn_fence(__ATOMIC_ACQUIRE, "agent");
            asm volatile("s_waitcnt vmcnt(0)" ::: "memory");
        }
    }
    __syncthreads();
}

constexpr int PH_PER_LAYER = 11;

#define SEAM(k) xcd_barrier(xbar)
template <int l>
__device__ __forceinline__ void layer_phases(LAS unsigned char* lds, const XcdBarrier xbar, cg::grid_group& grid, const int wave, const int G, const int bx, const int gw, const int NGW) {
    const int pb = 1 + l * PH_PER_LAYER; int tid, lane;
        if (l == 0) {
            {
                KA ka = ka_fresh(); tid = threadIdx.x; asm volatile("" : "+v"(tid)); lane = tid & 63; unsigned char* ws = ka->ws; bf16_t* HM = (bf16_t*)(ws + WS_HM); const float* modl = (const float*)(ws + WS_MOD) + (size_t)l * 2 * 6144;
                const float* xcur = ka->in[IN_X]; const float* gpm = ka->in[IN_GPM] + (size_t)l * D;
                for (int m = gw; m < M; m += NGW) { const int b = m / SEQ; const float* md = modl + (size_t)b * 6144;
                    prenorm_row(xcur + (size_t)m * D, gpm, md + 1024, md + 0, HM + (size_t)m * D, lane); }
            }
            SEAM(pb + 0);
        }
        {
            KA ka = ka_fresh(); tid = threadIdx.x; asm volatile("" : "+v"(tid)); lane = tid & 63; unsigned char* ws = ka->ws; unsigned char* wl = ws + WS_W + (size_t)l * W_LAYER;
            pg8::Gemm g{(const bf16_t*)(ws + WS_HM), (const bf16_t*)(wl + W_IN), M, NPAD, D, D, D}; pg8::StaticOrder S; S.init(M, NPAD, G, bx);
            pg8::EpiProj E{(bf16_t*)(ws + WS_P), (float*)(ws + WS_DT)};
            pg8::gemm_phase<pg8::EpiProj>(lds, g, S, E);
        }
        SEAM(pb + 1);
        {
            KA ka = ka_fresh(); tid = threadIdx.x; asm volatile("" : "+v"(tid)); lane = tid & 63; bf16_t* P = (bf16_t*)(ka->ws + WS_P);
            for (int u = bx; u < BATCH * SSD_NCH; u += G) ssd2_pass1(ka, l, P, u, lds, tid);
            __syncthreads();
            tid = threadIdx.x; asm volatile("" : "+v"(tid)); lane = tid & 63;
            for (int u = gw; u < BATCH * 4 * 512; u += NGW) attn_mfma_unit(P, u, lds + wave * 16384, lane);
            tid = threadIdx.x; asm volatile("" : "+v"(tid)); lane = tid & 63;
            if (G < 2) shortconv_phase(ka, l, P, tid, bx, G);
        }
        SEAM(pb + 2);
        { KA ka = ka_fresh(); tid = threadIdx.x; asm volatile("" : "+v"(tid)); lane = tid & 63; ssd2_scan_phase(ka, tid);
            if (l == 0 && G >= 2) {
                const int nscan = (BATCH * 8 * 4096) / NTHREADS < G ? (BATCH * 8 * 4096) / NTHREADS : 0;
                if (bx >= nscan) { LAS float* scr = (LAS float*)(lds + wave * 16384);
                    for (int it = (bx - nscan) * NWAVES + wave; it < TR_PER_LAYER; it += (G - nscan) * NWAVES) tr_dispatch(ka, TR_PER_LAYER + it, scr, lane); } }
            if (G >= 2) {
                const int nscan = (BATCH * 8 * 4096) / NTHREADS < G ? (BATCH * 8 * 4096) / NTHREADS : 0;
                if (nscan == 0) shortconv_phase(ka, l, (bf16_t*)(ka->ws + WS_P), tid, bx, G); else if (bx >= nscan) shortconv_phase(ka, l, (bf16_t*)(ka->ws + WS_P), tid, bx - nscan, G - nscan); } }
        SEAM(pb + 3);
        { KA ka = ka_fresh(); tid = threadIdx.x; asm volatile("" : "+v"(tid)); lane = tid & 63; bf16_t* P = (bf16_t*)(ka->ws + WS_P); for (int u = bx; u < BATCH * SSD_NCH; u += G) ssd2_pass3(ka, l, P, u, lds, tid); }
        SEAM(pb + 4);
        {
            KA ka = ka_fresh(); tid = threadIdx.x; asm volatile("" : "+v"(tid)); lane = tid & 63; unsigned char* ws = ka->ws; unsigned char* wl = ws + WS_W + (size_t)l * W_LAYER; bf16_t* P = (bf16_t*)(ws + WS_P);
            pg8::Gemm g{P + Y_OFF, (const bf16_t*)(wl + W_OUT3), M, D, D, YP, D}; pg8::StaticOrder S; S.init(M, D, G, bx);
            pg8::EpiGate3 E{(bf16_t*)(ws + WS_HM), P + G_OFF};
            pg8::gemm_phase<pg8::EpiGate3>(lds, g, S, E);
        }
        SEAM(pb + 5);
        {
            KA ka = ka_fresh(); tid = threadIdx.x; asm volatile("" : "+v"(tid)); lane = tid & 63; unsigned char* ws = ka->ws; unsigned char* wl = ws + WS_W + (size_t)l * W_LAYER;
            pg8::Gemm g{(const bf16_t*)(ws + WS_HM), (const bf16_t*)(wl + W_O), M, D, D, D, D}; pg8::StaticOrder S; S.init(M, D, G, bx);
            const float* modl = (const float*)(ws + WS_MOD) + (size_t)l * 2 * 6144;
            pg8::EpiResNorm<(l != 0), true> E{(l == 0) ? (const void*)ka->in[IN_X] : (const void*)ka->out, (void*)(ws + WS_P), modl + 2048, ka->in[IN_GPOM] + (size_t)l * D, 1, ka->in[IN_GPF] + (size_t)l * D, modl + 4096, modl + 3072,
                              (bf16_t*)(ws + WS_P + P_H2),
                              pg8::PanelSq{(float*)(ws + WS_XBUF) + (size_t)(l * 4 + 0) * 131072, (unsigned*)(ws + WS_PCNT), 32u * (unsigned)(l * 4 + 1)},
                              pg8::PanelSq{(float*)(ws + WS_XBUF) + (size_t)(l * 4 + 1) * 131072, (unsigned*)(ws + WS_PCNT), 32u * (unsigned)(l * 4 + 2)}};
            pg8::gemm_phase<pg8::EpiResNorm<(l != 0), true>>(lds, g, S, E);
        }
        SEAM(pb + 6);
        {
            KA ka = ka_fresh(); tid = threadIdx.x; asm volatile("" : "+v"(tid)); lane = tid & 63; unsigned char* ws = ka->ws; unsigned char* wl = ws + WS_W + (size_t)l * W_LAYER;
            pg8::Gemm g{(const bf16_t*)(ws + WS_P + P_H2), (const bf16_t*)(wl + W_FI), M, 2 * FFN, D, D, D}; pg8::StaticOrder S; S.init(M, 2 * FFN, G, bx);
            pg8::EpiSwiGLU E{(bf16_t*)(ws + WS_P + P_ACT)};
            pg8::gemm_phase<pg8::EpiSwiGLU>(lds, g, S, E);
        }
        SEAM(pb + 8);
        {
            KA ka = ka_fresh(); tid = threadIdx.x; asm volatile("" : "+v"(tid)); lane = tid & 63; unsigned char* ws = ka->ws; unsigned char* wl = ws + WS_W + (size_t)l * W_LAYER;
            pg8::Gemm g{(const bf16_t*)(ws + WS_P + P_ACT), (const bf16_t*)(wl + W_FO), M, D, FFN, FFN, FFN}; pg8::StaticOrder S; S.init(M, D, G, bx);
            constexpr bool nxt = (l + 1 < DEPTH); constexpr int ln = nxt ? l + 1 : l;
            const float* modl = (const float*)(ws + WS_MOD) + (size_t)l * 2 * 6144; const float* modn = (const float*)(ws + WS_MOD) + (size_t)ln * 2 * 6144;
            pg8::EpiResNorm<true, nxt> E{(const void*)(ws + WS_P), (void*)ka->out, modl + 5120, ka->in[IN_GPOF] + (size_t)l * D, nxt ? 1 : 0, ka->in[IN_GPM] + (size_t)ln * D, modn + 1024, modn + 0,
                              (bf16_t*)(ws + WS_HM),
                              pg8::PanelSq{(float*)(ws + WS_XBUF) + (size_t)(l * 4 + 2) * 131072, (unsigned*)(ws + WS_PCNT), 32u * (unsigned)(l * 4 + 3)},
                              pg8::PanelSq{(float*)(ws + WS_XBUF) + (size_t)(l * 4 + 3) * 131072, (unsigned*)(ws + WS_PCNT), 32u * (unsigned)(l * 4 + 4)}};
            pg8::gemm_phase<pg8::EpiResNorm<true, nxt>>(lds, g, S, E);
        }
        if (l + 1 < DEPTH) SEAM(pb + 9);
}

__global__ void __launch_bounds__(NTHREADS, 2) fwd_kernel(Args args_unused) {
    extern __shared__ __attribute__((aligned(16))) unsigned char lds_raw[];
    LAS unsigned char* lds = (LAS unsigned char*)lds_raw;
    int tid = threadIdx.x; asm volatile("" : "+v"(tid));
    int lane = tid & 63; const int wave = __builtin_amdgcn_readfirstlane(tid >> 6);
    const int G = gridDim.x, bx = blockIdx.x;
    const int gw = bx * NWAVES + wave, NGW = G * NWAVES;
    cg::grid_group grid = cg::this_grid();
    if (tid < 16) ((LAS unsigned*)(lds + LDS_BYTES - 64))[tid] = 0u;
    __syncthreads();
    XcdBarrier xbar; { KA ka = ka_fresh(); xbar = xcd_barrier_post((unsigned*)(ka->ws + WS_BAR), (volatile LAS unsigned*)(lds + LDS_BYTES - 64)); }

    if (gridDim.y == 12345u) grid.sync();
    {
        KA ka = ka_fresh(); tid = threadIdx.x; asm volatile("" : "+v"(tid)); lane = tid & 63;
        for (int it = bx; it < 192; it += G) mod_item(ka, it, (LAS float*)lds, tid);
        LAS float* scr = (LAS float*)(lds + wave * 16384);
        for (int it = gw; it < TR_PER_LAYER; it += NGW) tr_dispatch(ka, it, scr, lane);
    }
    SEAM(0);

    layer_phases<0>(lds, xbar, grid, wave, G, bx, gw, NGW);
    layer_phases<1>(lds, xbar, grid, wave, G, bx, gw, NGW);
#undef SEAM
}

extern "C" void kernel_launch(void* const* d_in, const int* in_sizes, int n_in, void* d_out, int out_size, void* d_ws, size_t ws_size, hipStream_t stream) {
    static int grid = 0;
    if (grid == 0) {
        if (n_in != 22 || out_size != M * D || ws_size < WS_END) { fprintf(stderr, "kernel_launch: unexpected shapes (n_in %d, out %d, ws %zu)\n", n_in, out_size, ws_size); grid = -1; return; }
        int dev = 0, cus = 0, per_cu = 0;
        hipGetDevice(&dev); hipDeviceGetAttribute(&cus, hipDeviceAttributeMultiprocessorCount, dev);
        if (hipFuncSetAttribute((const void*)fwd_kernel, hipFuncAttributeMaxDynamicSharedMemorySize, LDS_BYTES) != hipSuccess) { fprintf(stderr, "kernel_launch: hipFuncSetAttribute failed\n"); grid = -1; return; }
        if (hipOccupancyMaxActiveBlocksPerMultiprocessor(&per_cu, (const void*)fwd_kernel, NTHREADS, LDS_BYTES) != hipSuccess || per_cu < 1) { fprintf(stderr, "kernel_launch: occupancy query says %d\n", per_cu); per_cu = 1; }
        (void)hipGetLastError();
        grid = cus >= 256 ? 256 : cus;
    }
    if (grid < 0) return;
    if (hipMemsetAsync((unsigned char*)d_ws + WS_BAR, 0, 16384 + 32768, stream) != hipSuccess) { fprintf(stderr, "kernel_launch: memset failed\n"); return; }
    Args a{};
    for (int i = 0; i < 22; ++i) a.in[i] = (const float*)d_in[i];
    a.out = (float*)d_out; a.ws = (unsigned char*)d_ws;
    void* kargs[] = {&a};
    hipError_t e = hipLaunchCooperativeKernel((const void*)fwd_kernel, dim3(grid), dim3(NTHREADS), kargs, LDS_BYTES, stream);
    if (e != hipSuccess) fprintf(stderr, "kernel_launch: cooperative launch failed: %s (grid %d)\n", hipGetErrorString(e), grid);
}
```

```cpp
#include <hip/hip_runtime.h>
#include <hip/hip_cooperative_groups.h>
#include <cstdio>
#include <cstdint>
namespace cg = cooperative_groups;

#define LAS __attribute__((address_space(3)))
typedef unsigned short bf16_t;
typedef short bf16x8 __attribute__((ext_vector_type(8)));
typedef float f32x4 __attribute__((ext_vector_type(4)));
typedef float f32x2 __attribute__((ext_vector_type(2)));
typedef unsigned u32x4 __attribute__((ext_vector_type(4)));
typedef unsigned u32x2 __attribute__((ext_vector_type(2)));

constexpr int BATCH = 2, SEQ = 16384, D = 1024, M = BATCH * SEQ, DEPTH = 2;
constexpr int NSRC = 5896;
constexpr int NP = 5888;
constexpr int NPAD = 6144;
constexpr int FFN = 2816;
constexpr float EPS = 1e-6f;
constexpr int YP = 1024, QP = 1792, GP = 3072;
constexpr size_t Y_OFF = 0, Q_OFF = (size_t)M * YP, G_OFF = Q_OFF + (size_t)M * QP;
constexpr int YC_A = 0, YC_B = 256, YC_C = 512, QC_SCC = 0, QC_SCX = 256, QC_K = 512, QC_V = 768, QC_XBC = 1024;
static_assert((G_OFF + (size_t)M * GP) * 2 == (size_t)M * NP * 2, "region size");
constexpr int SSD_CH = 64, SSD_NCH = SEQ / SSD_CH;

constexpr size_t MiB = 1u << 20;
constexpr size_t WS_MOD = 0;
constexpr size_t WS_CD = 128 * 1024;
constexpr size_t WS_BAR = 512 * 1024;
constexpr size_t WS_DT = 1 * MiB;
constexpr size_t WS_W = 2 * MiB;
constexpr size_t W_LAYER = 33 * MiB, W_IN = 0, W_OUT3 = 12 * MiB, W_O = 14 * MiB, W_FI = 16 * MiB, W_FO = 27 * MiB;
constexpr size_t WS_P = 68 * MiB;
constexpr size_t WS_HM = 436 * MiB;
constexpr size_t WS_XBUF = 500 * MiB;
constexpr size_t WS_PCNT = 512 * 1024 + 16384;
constexpr size_t WS_END = 504 * MiB;
constexpr size_t P_H2 = 64 * MiB, P_ACT = 128 * MiB;

enum { IN_X = 0, IN_C, IN_MODW, IN_MODB, IN_GPM, IN_GPOM, IN_GPF, IN_GPOF, IN_WIN, IN_SCW, IN_SSMCW, IN_SSMCB, IN_DTB, IN_ALOG, IN_SSMD, IN_SSMNW, IN_WSC, IN_WSB, IN_WSSM, IN_WO, IN_WFI, IN_WFO };

struct Args { const float* in[22]; float* out; unsigned char* ws; int pad0, pad1; };
typedef const __attribute__((address_space(4))) Args* KA;
__device__ __forceinline__ KA ka_fresh() { KA p = (KA)__builtin_amdgcn_kernarg_segment_ptr(); asm volatile("" : "+s"(p)); return p; }

__device__ __forceinline__ float bf2f(bf16_t v) { return __uint_as_float((unsigned)v << 16); }
__device__ __forceinline__ float bflo(unsigned u) { return __uint_as_float(u << 16); }
__device__ __forceinline__ float bfhi(unsigned u) { return __uint_as_float(u & 0xffff0000u); }
__device__ __forceinline__ unsigned f2bf(float f) { unsigned u = __float_as_uint(f); return (u + 0x7fffu + ((u >> 16) & 1u)) >> 16; }
typedef __bf16 bf16x2_t __attribute__((ext_vector_type(2)));
__device__ __forceinline__ unsigned pk2(float lo, float hi) { f32x2 v = {lo, hi}; const bf16x2_t b = __builtin_convertvector(v, bf16x2_t); return __builtin_bit_cast(unsigned, b); }
__device__ __forceinline__ float wave_sum(float v) {
#pragma unroll
    for (int o = 1; o < 64; o <<= 1) v += __shfl_xor(v, o);
    return v;
}
__device__ __forceinline__ float sigmoidf_(float v) { return __builtin_amdgcn_rcpf(1.f + __expf(-v)); }
__device__ __forceinline__ float siluf_(float v) { return v * sigmoidf_(v); }
__device__ __forceinline__ float softplusf_(float z) { return fmaxf(z, 0.f) + __logf(1.f + __expf(-fabsf(z))); }
#define LDS_WAIT() asm volatile("s_waitcnt lgkmcnt(0)" ::: "memory")

namespace pg8 {
constexpr int BM = 256, BK = 64, HALF = 128, HTB = HALF * BK * 2, STAGE_BYTES = 8 * HTB, NXCD = 8, WGM = 4;
__device__ __forceinline__ int lds_byte(int r, int c) { const int st = (r >> 4) * 2 + (c >> 5), rr = r & 15, cc = c & 31, ob = rr * 64 + cc * 2; return st * 1024 + (ob ^ (((ob >> 9) & 1) << 5)); }
__device__ __forceinline__ void stage_rc(int b, int& R, int& C) { const int st = b / 1024, sb = b % 1024, swz = sb ^ (((sb >> 9) & 1) << 5); R = (st >> 1) * 16 + swz / 64; C = (st & 1) * 32 + (swz % 64) / 2; }
__device__ __forceinline__ int perm32(int rho) { const int n = rho >> 4, i = rho & 15; return 8 * (i >> 2) + 4 * n + (i & 3); }

struct Unit { int pm, pn; };
struct Gemm { const bf16_t* A; const bf16_t* Bt; int M, N, K, lda, ldb; };

struct StaticOrder {
    int nM, nN, nwg, G, c;
    __device__ void init(int M_, int N_, int G_, int c_) { nM = M_ / BM; nN = N_ / BM; nwg = nM * nN; asm volatile("" : "+s"(G_), "+s"(c_)); G = G_; c = c_; }
    __device__ bool next(int i, Unit& u) const {
        const long L = (long)i * G + c; if (L >= nwg) return false;
        int wgid = (int)L; { const int q = nwg / NXCD, r = nwg % NXCD, xcd = wgid % NXCD, off = wgid / NXCD; wgid = (xcd < r ? xcd * (q + 1) : r * (q + 1) + (xcd - r) * q) + off; }
        const int nig = WGM * nN, gid = wgid / nig, fm = gid * WGM, gsz = (nM - fm) < WGM ? (nM - fm) : WGM;
        u.pm = fm + ((wgid % nig) % gsz); u.pn = (wgid % nig) / gsz; return true;
    }
};


struct EpiProj {
    static constexpr bool FUSED = false, HOOK = false; bf16_t* P; float* DT;
    __device__ __forceinline__ void operator()(const f32x4 (&acc)[2][2][4][2], const Unit& u, int wr, int wc, int fr, int fq) const {
        asm volatile("" : "+v"(fr), "+v"(fq));
        const int row0 = u.pm * BM + wr * 64 + fr;
        if (u.pn == 23) {
            if (wc == 0 && fq == 0) {
#pragma unroll
                for (int ai = 0; ai < 2; ++ai)
#pragma unroll
                    for (int m = 0; m < 4; ++m) { float* d = DT + (size_t)(row0 + ai * HALF + m * 16) * 8;
                        *(f32x4*)d = acc[ai][0][m][0]; *(f32x4*)(d + 4) = acc[ai][0][m][1]; }
            }
            return;
        }
        bf16_t* base; int pitch, cb;
        if (u.pn < 4) { base = P + Y_OFF; pitch = YP; cb = u.pn * BM; } else if (u.pn < 11) { base = P + Q_OFF; pitch = QP; cb = (u.pn - 4) * BM; } else { base = P + G_OFF; pitch = GP; cb = (u.pn - 11) * BM; }
        const int col0 = cb + wc * 32 + 8 * fq;
#pragma unroll
        for (int ai = 0; ai < 2; ++ai)
#pragma unroll
            for (int m = 0; m < 4; ++m) { bf16_t* rowp = base + (size_t)(row0 + ai * HALF + m * 16) * pitch + col0;
#pragma unroll
                for (int bj = 0; bj < 2; ++bj) { f32x4 v0 = acc[ai][bj][m][0], v1 = acc[ai][bj][m][1];
                    if (u.pn >= 11) {
#pragma unroll
                        for (int e = 0; e < 4; ++e) { v0[e] = __expf(fminf(-v0[e], 60.f)); v1[e] = __expf(fminf(-v1[e], 60.f)); } }
                    u32x4 w; w.x = pk2(v0[0], v0[1]); w.y = pk2(v0[2], v0[3]); w.z = pk2(v1[0], v1[1]); w.w = pk2(v1[2], v1[3]);
                    *(u32x4*)(rowp + bj * HALF) = w; } }
    }
};

struct EpiGate3 {
    static constexpr bool FUSED = false, HOOK = true;
    bf16_t* O; const bf16_t* G;
    static __device__ __forceinline__ float en(float u) { return u; }
    __device__ __forceinline__ void hook(f32x4 (&acc)[2][2][4][2], const Unit& u, int t, int wr, int wc, int fr, int fq) const {
        asm volatile("" : "+v"(fr), "+v"(fq));
        const int row0 = u.pm * BM + wr * 64 + fr, col0 = u.pn * BM + wc * 32 + 8 * fq;
        const bf16_t* gp = G + (t == 4 ? 0 : 1024);
#pragma unroll
        for (int ai = 0; ai < 2; ++ai)
#pragma unroll
            for (int m = 0; m < 4; ++m) { const size_t row = (size_t)(row0 + ai * HALF + m * 16);
#pragma unroll
                for (int bj = 0; bj < 2; ++bj) { const bf16_t* p = gp + row * GP + col0 + bj * HALF;
                    const u32x4 a = *(const u32x4*)p, b = *(const u32x4*)(p + 1024);
                    f32x4 r0, r1;
                    r0[0] = (1.f + en(bflo(b.x))) * __builtin_amdgcn_rcpf(1.f + en(bflo(a.x))); r0[1] = (1.f + en(bfhi(b.x))) * __builtin_amdgcn_rcpf(1.f + en(bfhi(a.x)));
                    r0[2] = (1.f + en(bflo(b.y))) * __builtin_amdgcn_rcpf(1.f + en(bflo(a.y))); r0[3] = (1.f + en(bfhi(b.y))) * __builtin_amdgcn_rcpf(1.f + en(bfhi(a.y)));
                    r1[0] = (1.f + en(bflo(b.z))) * __builtin_amdgcn_rcpf(1.f + en(bflo(a.z))); r1[1] = (1.f + en(bfhi(b.z))) * __builtin_amdgcn_rcpf(1.f + en(bfhi(a.z)));
                    r1[2] = (1.f + en(bflo(b.w))) * __builtin_amdgcn_rcpf(1.f + en(bflo(a.w))); r1[3] = (1.f + en(bfhi(b.w))) * __builtin_amdgcn_rcpf(1.f + en(bfhi(a.w)));
                    acc[ai][bj][m][0] *= r0; acc[ai][bj][m][1] *= r1; }
                asm volatile("" ::: "memory"); }
    }
    __device__ __forceinline__ void operator()(const f32x4 (&acc)[2][2][4][2], const Unit& u, int wr, int wc, int fr, int fq) const {
        asm volatile("" : "+v"(fr), "+v"(fq));
        const int row0 = u.pm * BM + wr * 64 + fr, col0 = u.pn * BM + wc * 32 + 8 * fq;
#pragma unroll
        for (int ai = 0; ai < 2; ++ai)
#pragma unroll
            for (int m = 0; m < 4; ++m) { const size_t row = (size_t)(row0 + ai * HALF + m * 16);
#pragma unroll
                for (int bj = 0; bj < 2; ++bj) { const f32x4 v0 = acc[ai][bj][m][0], v1 = acc[ai][bj][m][1];
                    const u32x4 g = *(const u32x4*)(G + 2048 + row * GP + col0 + bj * HALF);
                    u32x4 w;
                    w.x = pk2(v0[0] * __builtin_amdgcn_rcpf(1.f + en(bflo(g.x))), v0[1] * __builtin_amdgcn_rcpf(1.f + en(bfhi(g.x)))); w.y = pk2(v0[2] * __builtin_amdgcn_rcpf(1.f + en(bflo(g.y))), v0[3] * __builtin_amdgcn_rcpf(1.f + en(bfhi(g.y))));
                    w.z = pk2(v1[0] * __builtin_amdgcn_rcpf(1.f + en(bflo(g.z))), v1[1] * __builtin_amdgcn_rcpf(1.f + en(bfhi(g.z)))); w.w = pk2(v1[2] * __builtin_amdgcn_rcpf(1.f + en(bflo(g.w))), v1[3] * __builtin_amdgcn_rcpf(1.f + en(bfhi(g.w))));
                    *(u32x4*)(O + row * D + col0 + bj * HALF) = w; }
                asm volatile("" ::: "memory"); }
    }
};
struct EpiSwiGLU {
    static constexpr bool FUSED = false, HOOK = false; bf16_t* O;
    __device__ __forceinline__ void operator()(const f32x4 (&acc)[2][2][4][2], const Unit& u, int wr, int wc, int fr, int fq) const {
        asm volatile("" : "+v"(fr), "+v"(fq));
        const int row0 = u.pm * BM + wr * 64 + fr, col0 = u.pn * HALF + wc * 32 + 8 * fq;
#pragma unroll
        for (int ai = 0; ai < 2; ++ai)
#pragma unroll
            for (int m = 0; m < 4; ++m) { bf16_t* rowp = O + (size_t)(row0 + ai * HALF + m * 16) * FFN + col0;
                const f32x4 g0 = acc[ai][0][m][0], g1 = acc[ai][0][m][1], u0 = acc[ai][1][m][0], u1 = acc[ai][1][m][1];
                u32x4 w; w.x = pk2(siluf_(g0[0]) * u0[0], siluf_(g0[1]) * u0[1]); w.y = pk2(siluf_(g0[2]) * u0[2], siluf_(g0[3]) * u0[3]);
                w.z = pk2(siluf_(g1[0]) * u1[0], siluf_(g1[1]) * u1[1]); w.w = pk2(siluf_(g1[2]) * u1[2], siluf_(g1[3]) * u1[3]);
                *(u32x4*)rowp = w; }
    }
};


struct PanelSq {
    float* xbuf;
    unsigned* cnt;
    unsigned need;
    __device__ __forceinline__ void run(const f32x4 (&v)[2][2][4][2], const Unit& u, int wr, int wc, int fr, int fq, LAS unsigned char* ldsx, int wid, int lane) const {
        LAS float* Pp = (LAS float*)ldsx; LAS float* S = (LAS float*)(ldsx + 4096);
#pragma unroll
        for (int ai = 0; ai < 2; ++ai)
#pragma unroll
            for (int m = 0; m < 4; ++m) {
                float q = 0.f;
#pragma unroll
                for (int bj = 0; bj < 2; ++bj)
#pragma unroll
                    for (int n = 0; n < 2; ++n) { const f32x4 x = v[ai][bj][m][n]; q += (x[0] * x[0] + x[1] * x[1]) + (x[2] * x[2] + x[3] * x[3]); }
                q += __shfl_xor(q, 16); q += __shfl_xor(q, 32);
                if (fq == 0) Pp[(ai * HALF + wr * 64 + m * 16 + fr) * 4 + wc] = q;
            }
        asm volatile("s_waitcnt lgkmcnt(0)" ::: "memory"); __builtin_amdgcn_s_barrier(); asm volatile("" ::: "memory");
        const int row = wid * 32 + (lane & 31);
        if (lane < 32) {
            const float q = (Pp[row * 4 + 0] + Pp[row * 4 + 1]) + (Pp[row * 4 + 2] + Pp[row * 4 + 3]);
            __hip_atomic_store(xbuf + ((size_t)(u.pm * BM + row) * 4 + u.pn), q, __ATOMIC_RELAXED, __HIP_MEMORY_SCOPE_AGENT);
        }
        asm volatile("s_waitcnt vmcnt(0)" ::: "memory");
        if (lane == 0) __hip_atomic_fetch_add(cnt + 64 * u.pm, 1u, __ATOMIC_RELAXED, __HIP_MEMORY_SCOPE_AGENT);
        if (wid == 0) {
            unsigned sp = 0;
            while ((unsigned)__builtin_amdgcn_readfirstlane(__hip_atomic_load(cnt + 64 * u.pm, __ATOMIC_RELAXED, __HIP_MEMORY_SCOPE_AGENT)) < need) { __builtin_amdgcn_s_sleep(2); if (++sp > (1u << 22)) break; }
            __builtin_amdgcn_fence(__ATOMIC_ACQUIRE, "agent");
        }
        asm volatile("s_waitcnt vmcnt(0) lgkmcnt(0)" ::: "memory"); __builtin_amdgcn_s_barrier(); asm volatile("" ::: "memory");
        if (lane < 32) {
            const float* slot = xbuf + (size_t)(u.pm * BM + row) * 4; float t = 0.f;
#pragma unroll
            for (int k = 0; k < 4; ++k) t += __hip_atomic_load(slot + k, __ATOMIC_RELAXED, __HIP_MEMORY_SCOPE_AGENT);
            S[row] = t;
        }
        asm volatile("s_waitcnt lgkmcnt(0)" ::: "memory"); __builtin_amdgcn_s_barrier(); asm volatile("" ::: "memory");
    }
};
template <bool XIN_BF16, bool XOUT_BF16> struct EpiResNorm {
    static constexpr bool FUSED = true, HOOK = false;
    __device__ __forceinline__ void load8(size_t off, f32x4& v0, f32x4& v1) const {
        if (XIN_BF16) { const u32x4 w = *(const u32x4*)((const bf16_t*)xin + off); v0 = (f32x4){bflo(w.x), bfhi(w.x), bflo(w.y), bfhi(w.y)}; v1 = (f32x4){bflo(w.z), bfhi(w.z), bflo(w.w), bfhi(w.w)}; }
        else { v0 = *(const f32x4*)((const float*)xin + off); v1 = *(const f32x4*)((const float*)xin + off + 4); } }
    __device__ __forceinline__ void store8(size_t off, const f32x4& v0, const f32x4& v1) const {
        if (XOUT_BF16) { u32x4 w; w.x = pk2(v0[0], v0[1]); w.y = pk2(v0[2], v0[3]); w.z = pk2(v1[0], v1[1]); w.w = pk2(v1[2], v1[3]); *(u32x4*)((bf16_t*)xout + off) = w; }
        else { *(f32x4*)((float*)xout + off) = v0; *(f32x4*)((float*)xout + off + 4) = v1; } }
    const void* xin; void* xout; const float* gate; const float* gpost; int do_next; const float* gn; const float* scn; const float* shn; bf16_t* hout; PanelSq st1, st2;
    __device__ __forceinline__ void fused(f32x4 (&acc)[2][2][4][2], const Unit& u, int wr, int wc, int fr, int fq, LAS unsigned char* ldsx, int wid, int lane) const {
        asm volatile("" : "+v"(fr), "+v"(fq));
        const LAS float* S = (const LAS float*)(ldsx + 4096);
        const int col0 = u.pn * BM + wc * 32 + 8 * fq;
        const int boff = (u.pm * BM >= SEQ) ? 6144 : 0;
        const float* gate = this->gate + boff; const float* scn = this->scn + boff; const float* shn = this->shn + boff;
        f32x4 g1[2][2];
#pragma unroll
        for (int bj = 0; bj < 2; ++bj)
#pragma unroll
            for (int n = 0; n < 2; ++n) { const int c = bj * HALF + 4 * n; g1[bj][n] = *(const f32x4*)(gate + col0 + c) * *(const f32x4*)(gpost + col0 + c); }
        f32x4 pre[2][2][2];
#pragma unroll
        for (int m = 0; m < 2; ++m) { const size_t off = (size_t)(u.pm * BM + wr * 64 + m * 16 + fr) * 1024 + col0;
#pragma unroll
            for (int bj = 0; bj < 2; ++bj) load8(off + bj * HALF, pre[m][bj][0], pre[m][bj][1]); }
        st1.run(acc, u, wr, wc, fr, fq, ldsx, wid, lane);
#pragma unroll
        for (int ai = 0; ai < 2; ++ai)
#pragma unroll
            for (int m = 0; m < 4; ++m) { const int r = ai * HALF + wr * 64 + m * 16 + fr; const float rs = __builtin_amdgcn_rsqf(S[r] * (1.f / 1024.f) + EPS); const size_t off = (size_t)(u.pm * BM + r) * 1024 + col0;
#pragma unroll
                for (int bj = 0; bj < 2; ++bj) { f32x4 xv0, xv1;
                    if (ai == 0 && m < 2) { xv0 = pre[m & 1][bj][0]; xv1 = pre[m & 1][bj][1]; } else load8(off + bj * HALF, xv0, xv1);
                    const f32x4 x10 = xv0 + g1[bj][0] * (acc[ai][bj][m][0] * rs), x11 = xv1 + g1[bj][1] * (acc[ai][bj][m][1] * rs);
                    store8(off + bj * HALF, x10, x11); acc[ai][bj][m][0] = x10; acc[ai][bj][m][1] = x11; }
                asm volatile("" : "+v"(acc[ai][0][m][0]), "+v"(acc[ai][0][m][1]), "+v"(acc[ai][1][m][0]), "+v"(acc[ai][1][m][1]));
                if (m & 1) asm volatile("" ::: "memory"); }
        if (do_next) {
            f32x4 a2[2][2], b2[2][2];
#pragma unroll
            for (int bj = 0; bj < 2; ++bj)
#pragma unroll
                for (int n = 0; n < 2; ++n) { const int c = bj * HALF + 4 * n; a2[bj][n] = *(const f32x4*)(gn + col0 + c) * (*(const f32x4*)(scn + col0 + c) + 1.f); b2[bj][n] = *(const f32x4*)(shn + col0 + c); }
            st2.run(acc, u, wr, wc, fr, fq, ldsx, wid, lane);
#pragma unroll
            for (int ai = 0; ai < 2; ++ai)
#pragma unroll
                for (int m = 0; m < 4; ++m) { const int r = ai * HALF + wr * 64 + m * 16 + fr; const float rs = __builtin_amdgcn_rsqf(S[r] * (1.f / 1024.f) + EPS); const size_t off = (size_t)(u.pm * BM + r) * 1024 + col0;
#pragma unroll
                    for (int bj = 0; bj < 2; ++bj) { const f32x4 h0 = acc[ai][bj][m][0] * rs * a2[bj][0] + b2[bj][0], h1 = acc[ai][bj][m][1] * rs * a2[bj][1] + b2[bj][1];
                        u32x4 w; w.x = pk2(h0[0], h0[1]); w.y = pk2(h0[2], h0[3]); w.z = pk2(h1[0], h1[1]); w.w = pk2(h1[2], h1[3]);
                        *(u32x4*)(hout + off + bj * HALF) = w; } }
        }
    }
};

template <class Epi>
__device__ __forceinline__ void gemm_phase(LAS unsigned char* lds, const Gemm g, const StaticOrder& S, const Epi& E) {
    int tid = threadIdx.x; asm volatile("" : "+v"(tid));
    const int wid = __builtin_amdgcn_readfirstlane(tid >> 6), lane = tid & 63, wr = wid >> 2, wc = wid & 3, fr = lane & 15, fq = lane >> 4;
    const int K = g.K, nt = K / BK;
    unsigned voffA[2], voffB[2];
#pragma unroll
    for (int i = 0; i < 2; ++i) { int R, C; stage_rc(tid * 16 + i * 8192, R, C); const int Rb = (R & ~31) + perm32(R & 31);
        voffA[i] = (unsigned)(R * g.lda + C) * 2u; voffB[i] = (unsigned)(Rb * g.ldb + C) * 2u; }
    const size_t kstep = (size_t)(BK * 2);
    const size_t hstepA = (size_t)HALF * g.lda * 2, hstepB = (size_t)HALF * g.ldb * 2;
    const size_t tstepA = 2 * hstepA, tstepB = 2 * hstepB;
    const unsigned ldsw = (unsigned)wid * 1024u;
    const int aoff = lds_byte(wr * 64 + fr, fq * 8), boff = lds_byte(wc * 32 + fr, fq * 8);
#define PG8_SA(b, h) (((b) * 2 + (h)) * HTB)
#define PG8_SB(b, h) ((4 + (b) * 2 + (h)) * HTB)
#define PG8_STAGE(bufoff, gbase, voff) do { _Pragma("unroll") for (int _i = 0; _i < 2; ++_i) \
        __builtin_amdgcn_global_load_lds((const unsigned*)((const char*)(gbase) + (voff)[_i]), (LAS unsigned*)(lds + (bufoff) + ldsw + _i * 8192), 16, 0, 0); } while (0)
#define PG8_LDA(dst, b, h) do { _Pragma("unroll") for (int m = 0; m < 4; ++m) _Pragma("unroll") for (int k = 0; k < 2; ++k) dst[m][k] = *(const LAS bf16x8*)(lds + PG8_SA(b, h) + aoff + m * 2048 + k * 1024); } while (0)
#define PG8_LDB(dst, b, h) do { _Pragma("unroll") for (int n = 0; n < 2; ++n) _Pragma("unroll") for (int k = 0; k < 2; ++k) dst[n][k] = *(const LAS bf16x8*)(lds + PG8_SB(b, h) + boff + n * 2048 + k * 1024); } while (0)
#define PG8_MMA(ai, bj, At, Bt) do { __builtin_amdgcn_s_setprio(1); _Pragma("unroll") for (int m = 0; m < 4; ++m) _Pragma("unroll") for (int n = 0; n < 2; ++n) _Pragma("unroll") for (int k = 0; k < 2; ++k) \
        acc[ai][bj][m][n] = __builtin_amdgcn_mfma_f32_16x16x32_bf16(Bt[n][k], At[m][k], acc[ai][bj][m][n], 0, 0, 0); __builtin_amdgcn_s_setprio(0); } while (0)
#define PG8_WAIT_V(n) asm volatile("s_waitcnt vmcnt(" #n ")" ::: "memory")
#define PG8_WAIT_L(n) asm volatile("s_waitcnt lgkmcnt(" #n ")" ::: "memory")
#define PG8_BAR __builtin_amdgcn_s_barrier()
#define PG8_SCHED __builtin_amdgcn_sched_barrier(0)
    Unit cur, nxt; int ui = 0;
    if (!S.next(0, cur)) return;
    f32x4 acc[2][2][4][2];
#pragma unroll
    for (int a = 0; a < 2; ++a)
#pragma unroll
        for (int b = 0; b < 2; ++b)
#pragma unroll
            for (int m = 0; m < 4; ++m)
#pragma unroll
                for (int n = 0; n < 2; ++n) acc[a][b][m][n] = (f32x4){0.f, 0.f, 0.f, 0.f};
    bf16x8 At[4][2], B0[2][2], B1[2][2];
    const char* cA = (const char*)g.A + (size_t)cur.pm * tstepA; const char* cB = (const char*)g.Bt + (size_t)cur.pn * tstepB;
    PG8_STAGE(PG8_SB(0, 0), cB, voffB); PG8_STAGE(PG8_SB(0, 1), cB + hstepB, voffB); PG8_STAGE(PG8_SA(0, 0), cA, voffA); PG8_STAGE(PG8_SA(0, 1), cA + hstepA, voffA);
    if (wr == 1) PG8_BAR;
    PG8_WAIT_V(2); PG8_BAR;
    PG8_STAGE(PG8_SB(1, 0), cB + kstep, voffB); PG8_STAGE(PG8_SA(1, 0), cA + kstep, voffA); PG8_STAGE(PG8_SB(1, 1), cB + hstepB + kstep, voffB);
    PG8_WAIT_V(6); PG8_BAR;
    for (;;) {
        const bool has_next = S.next(ui + 1, nxt);
        const char* nA = has_next ? (const char*)g.A + (size_t)nxt.pm * tstepA : cA; const char* nB = has_next ? (const char*)g.Bt + (size_t)nxt.pn * tstepB : cB;
#pragma unroll 1
        for (int t = 0; t < nt; t += 2) {
            if constexpr (Epi::HOOK) { if (t == 4 || t == 8) E.hook(acc, cur, t, wr, wc, fr, fq); }
            const bool last = (t == nt - 2);
            const char* a1 = cA + (size_t)(t + 1) * kstep;
            const char* a2 = last ? nA : cA + (size_t)(t + 2) * kstep; const char* b2 = last ? nB : cB + (size_t)(t + 2) * kstep;
            const char* a3 = a2 + kstep; const char* b3 = b2 + kstep;
            PG8_LDB(B0, 0, 0); PG8_LDB(B1, 0, 1); PG8_SCHED; PG8_LDA(At, 0, 0); PG8_STAGE(PG8_SA(1, 1), a1 + hstepA, voffA);
            PG8_WAIT_V(8); PG8_WAIT_L(0); PG8_BAR; PG8_MMA(0, 0, At, B0); PG8_MMA(0, 1, At, B1); PG8_BAR; PG8_SCHED;
            PG8_LDA(At, 0, 1); PG8_STAGE(PG8_SB(0, 0), b2, voffB); PG8_STAGE(PG8_SB(0, 1), b2 + hstepB, voffB); PG8_STAGE(PG8_SA(0, 0), a2, voffA);
            PG8_WAIT_V(8); PG8_WAIT_L(0); PG8_BAR; PG8_MMA(1, 0, At, B0); PG8_MMA(1, 1, At, B1); PG8_BAR; PG8_SCHED;
            PG8_LDB(B0, 1, 0); PG8_LDB(B1, 1, 1); PG8_SCHED; PG8_LDA(At, 1, 0); PG8_STAGE(PG8_SA(0, 1), a2 + hstepA, voffA);
            PG8_WAIT_V(8); PG8_WAIT_L(0); PG8_BAR; PG8_MMA(0, 0, At, B0); PG8_MMA(0, 1, At, B1); PG8_BAR; PG8_SCHED;
            PG8_LDA(At, 1, 1); PG8_STAGE(PG8_SB(1, 0), b3, voffB); PG8_STAGE(PG8_SB(1, 1), b3 + hstepB, voffB); PG8_STAGE(PG8_SA(1, 0), a3, voffA);
            PG8_WAIT_V(8); PG8_WAIT_L(0); PG8_BAR; PG8_MMA(1, 0, At, B0); PG8_MMA(1, 1, At, B1); PG8_BAR; PG8_SCHED;
        }
        if (wr == 0) PG8_BAR;
        if constexpr (Epi::FUSED) E.fused(acc, cur, wr, wc, fr, fq, lds + STAGE_BYTES, wid, lane); else E(acc, cur, wr, wc, fr, fq);
        if (!has_next) break;
#pragma unroll
        for (int a = 0; a < 2; ++a)
#pragma unroll
            for (int b = 0; b < 2; ++b)
#pragma unroll
                for (int m = 0; m < 4; ++m)
#pragma unroll
                    for (int n = 0; n < 2; ++n) acc[a][b][m][n] = (f32x4){0.f, 0.f, 0.f, 0.f};
        cur = nxt; cA = nA; cB = nB; ++ui;
        if (wr == 1) PG8_BAR;
    }
    PG8_WAIT_V(0);
    PG8_BAR;
#undef PG8_SA
#undef PG8_SB
#undef PG8_STAGE
#undef PG8_LDA
#undef PG8_LDB
#undef PG8_MMA
#undef PG8_WAIT_V
#undef PG8_WAIT_L
#undef PG8_BAR
#undef PG8_SCHED
}
}

constexpr int NWAVES = 8, NTHREADS = 512;
constexpr int LDS_BYTES = 147456;

__device__ __forceinline__ void tr_item(const float* W, int ldw, int src_col0, int nvalid, int k0, bf16_t* WT, int ldwt, int dst_row0, int dst_col0, LAS float* scr, int lane) {
    const int kr = lane >> 3, jq = lane & 7;
    f32x4 v[8];
#pragma unroll
    for (int i = 0; i < 8; ++i) { v[i] = (f32x4){0.f, 0.f, 0.f, 0.f}; if (4 * jq < nvalid) v[i] = *(const f32x4*)(W + (size_t)(k0 + 8 * i + kr) * ldw + src_col0 + 4 * jq); }
#pragma unroll
    for (int i = 0; i < 8; ++i) { LAS float* d = scr + (8 * i + kr) * 33 + 4 * jq; d[0] = v[i][0]; d[1] = v[i][1]; d[2] = v[i][2]; d[3] = v[i][3]; }
    LDS_WAIT();
    const int c = lane & 7;
#pragma unroll
    for (int q = 0; q < 4; ++q) { const int n = (lane >> 3) + 8 * q; const LAS float* s = scr + (8 * c) * 33 + n;
        u32x4 o; o.x = pk2(s[0 * 33], s[1 * 33]); o.y = pk2(s[2 * 33], s[3 * 33]); o.z = pk2(s[4 * 33], s[5 * 33]); o.w = pk2(s[6 * 33], s[7 * 33]);
        *(u32x4*)(WT + (size_t)(dst_row0 + n) * ldwt + dst_col0 + k0 + 8 * c) = o; }
    LDS_WAIT();
}
__device__ __forceinline__ void win_map(int d0, int& src, int& nvalid) {
    nvalid = 32;
    if (d0 < 256) src = d0;
    else if (d0 < 512) src = 768 + (d0 - 256);
    else if (d0 < 1024) src = 1536 + (d0 - 512);
    else if (d0 < 1280) src = 256 + (d0 - 1024);
    else if (d0 < 1536) src = 512 + (d0 - 1280);
    else if (d0 < 1792) src = 1024 + (d0 - 1536);
    else if (d0 < 2048) src = 1280 + (d0 - 1792);
    else if (d0 < 2816) src = d0;
    else if (d0 < 5888) src = d0 + 8;
    else if (d0 == 5888) { src = 2816; nvalid = 8; }
    else { src = 0; nvalid = 0; }
}
constexpr int TR_PER_LAYER = 3072 + 128 + 128 + 256 + 512 + 2816 + 1408;
__device__ __forceinline__ void tr_dispatch(KA a, int it, LAS float* scr, int lane) {
    const int l = it / TR_PER_LAYER; int r = it % TR_PER_LAYER;
    unsigned char* wl = a->ws + WS_W + (size_t)l * W_LAYER;
    if (r < 3072) { const int kb = r / 192, nb = r % 192, d0 = nb * 32; int src, nv; win_map(d0, src, nv);
        tr_item(a->in[IN_WIN] + (size_t)l * D * NSRC, NSRC, src, nv, kb * 64, (bf16_t*)(wl + W_IN), D, d0, 0, scr, lane); return; }
    r -= 3072;
    if (r < 128) { const int kb = r / 32, nb = r % 32; tr_item(a->in[IN_WSC] + (size_t)l * 256 * D, D, nb * 32, 32, kb * 64, (bf16_t*)(wl + W_OUT3), D, nb * 32, 0, scr, lane); return; }
    r -= 128;
    if (r < 128) { const int kb = r / 32, nb = r % 32; tr_item(a->in[IN_WSB] + (size_t)l * 256 * D, D, nb * 32, 32, kb * 64, (bf16_t*)(wl + W_OUT3), D, nb * 32, 256, scr, lane); return; }
    r -= 128;
    if (r < 256) { const int kb = r / 32, nb = r % 32; tr_item(a->in[IN_WSSM] + (size_t)l * 512 * D, D, nb * 32, 32, kb * 64, (bf16_t*)(wl + W_OUT3), D, nb * 32, 512, scr, lane); return; }
    r -= 256;
    if (r < 512) { const int kb = r / 32, nb = r % 32; tr_item(a->in[IN_WO] + (size_t)l * D * D, D, nb * 32, 32, kb * 64, (bf16_t*)(wl + W_O), D, nb * 32, 0, scr, lane); return; }
    r -= 512;
    if (r < 2816) { const int kb = r / 176, nb = r % 176, d0 = nb * 32, pn = d0 >> 8, within = d0 & 255, half = within >> 7, i = within & 127;
        tr_item(a->in[IN_WFI] + (size_t)l * D * 2 * FFN, 2 * FFN, half * FFN + pn * 128 + i, 32, kb * 64, (bf16_t*)(wl + W_FI), D, d0, 0, scr, lane); return; }
    r -= 2816;
    { const int kb = r / 32, nb = r % 32; tr_item(a->in[IN_WFO] + (size_t)l * FFN * D, D, nb * 32, 32, kb * 64, (bf16_t*)(wl + W_FO), FFN, nb * 32, 0, scr, lane); }
}
__device__ __forceinline__ void mod_item(KA a, int item, LAS float* red, int tid) {
    const int l = item / 96, nb = item % 96, n0 = nb * 64, j4 = tid & 15, ks = tid >> 4;
    const float* w = a->in[IN_MODW] + (size_t)l * D * 6144 + n0 + 4 * j4; const float* c = a->in[IN_C];
    f32x4 a0 = {0.f, 0.f, 0.f, 0.f}, a1 = {0.f, 0.f, 0.f, 0.f};
#pragma unroll 16
    for (int k = ks * 32; k < ks * 32 + 32; ++k) { const f32x4 wv = *(const f32x4*)(w + (size_t)k * 6144); a0 += wv * siluf_(c[k]); a1 += wv * siluf_(c[D + k]); }
    *(LAS f32x4*)(red + (ks * 2 + 0) * 64 + 4 * j4) = a0; *(LAS f32x4*)(red + (ks * 2 + 1) * 64 + 4 * j4) = a1;
    __syncthreads();
    if (tid < 128) { const int b = tid >> 6, j = tid & 63; float s = 0.f;
#pragma unroll
        for (int q = 0; q < 32; ++q) s += red[(q * 2 + b) * 64 + j];
        ((float*)(a->ws + WS_MOD))[(size_t)(l * 2 + b) * 6144 + n0 + j] = s + a->in[IN_MODB][(size_t)l * 6144 + n0 + j]; }
    __syncthreads();
}

__device__ __forceinline__ void prenorm_row(const float* xrow, const float* g, const float* scale, const float* shift, bf16_t* hrow, int lane) {
    f32x4 v[4]; float ss = 0.f;
#pragma unroll
    for (int j = 0; j < 4; ++j) { v[j] = *(const f32x4*)(xrow + 4 * lane + 256 * j); ss += (v[j][0] * v[j][0] + v[j][1] * v[j][1]) + (v[j][2] * v[j][2] + v[j][3] * v[j][3]); }
    const float rs = 1.0f / sqrtf(wave_sum(ss) * (1.f / D) + EPS);
#pragma unroll
    for (int j = 0; j < 4; ++j) { const int col = 4 * lane + 256 * j;
        const f32x4 gg = *(const f32x4*)(g + col), sc = *(const f32x4*)(scale + col), sh = *(const f32x4*)(shift + col);
        const f32x4 h = v[j] * rs * gg * (sc + 1.f) + sh;
        u32x2 w; w.x = pk2(h[0], h[1]); w.y = pk2(h[2], h[3]); *(u32x2*)(hrow + col) = w; }
}
__device__ __forceinline__ void shortconv_phase(KA a, int l, bf16_t* P, int tid, int vb, int nb) {
    const float* scw = a->in[IN_SCW] + (size_t)l * 3 * 256;
    for (int it = vb * NTHREADS + tid; it < (M / 8) * 32; it += nb * NTHREADS) {
        const int cg8 = it & 31, rb = it >> 5, row0 = rb * 8, tseq = row0 & (SEQ - 1), ch0 = cg8 * 8;
        float w0[8], w1[8], w2[8], c1[8], c2[8];
#pragma unroll
        for (int i = 0; i < 8; ++i) { w0[i] = scw[ch0 + i]; w1[i] = scw[256 + ch0 + i]; w2[i] = scw[512 + ch0 + i]; c1[i] = 0.f; c2[i] = 0.f; }
        if (tseq != 0) {
            const bf16_t* r2 = P + Q_OFF + (size_t)(row0 - 2) * QP + ch0; const bf16_t* r1 = P + Q_OFF + (size_t)(row0 - 1) * QP + ch0;
            const u32x4 cc2 = *(const u32x4*)(r2 + QC_SCC), xx2 = *(const u32x4*)(r2 + QC_SCX), cc1 = *(const u32x4*)(r1 + QC_SCC), xx1 = *(const u32x4*)(r1 + QC_SCX);
            c2[0] = bflo(cc2.x) * bflo(xx2.x); c2[1] = bfhi(cc2.x) * bfhi(xx2.x); c2[2] = bflo(cc2.y) * bflo(xx2.y); c2[3] = bfhi(cc2.y) * bfhi(xx2.y);
            c2[4] = bflo(cc2.z) * bflo(xx2.z); c2[5] = bfhi(cc2.z) * bfhi(xx2.z); c2[6] = bflo(cc2.w) * bflo(xx2.w); c2[7] = bfhi(cc2.w) * bfhi(xx2.w);
            c1[0] = bflo(cc1.x) * bflo(xx1.x); c1[1] = bfhi(cc1.x) * bfhi(xx1.x); c1[2] = bflo(cc1.y) * bflo(xx1.y); c1[3] = bfhi(cc1.y) * bfhi(xx1.y);
            c1[4] = bflo(cc1.z) * bflo(xx1.z); c1[5] = bfhi(cc1.z) * bfhi(xx1.z); c1[6] = bflo(cc1.w) * bflo(xx1.w); c1[7] = bfhi(cc1.w) * bfhi(xx1.w);
        }
#pragma unroll
        for (int r = 0; r < 8; ++r) {
            bf16_t* yp = P + Y_OFF + (size_t)(row0 + r) * YP + ch0 + YC_A; const bf16_t* qp = P + Q_OFF + (size_t)(row0 + r) * QP + ch0;
            const u32x4 bb = *(const u32x4*)yp, cc = *(const u32x4*)(qp + QC_SCC), xx = *(const u32x4*)(qp + QC_SCX);
            float c0[8], bv[8], y[8];
            c0[0] = bflo(cc.x) * bflo(xx.x); c0[1] = bfhi(cc.x) * bfhi(xx.x); c0[2] = bflo(cc.y) * bflo(xx.y); c0[3] = bfhi(cc.y) * bfhi(xx.y);
            c0[4] = bflo(cc.z) * bflo(xx.z); c0[5] = bfhi(cc.z) * bfhi(xx.z); c0[6] = bflo(cc.w) * bflo(xx.w); c0[7] = bfhi(cc.w) * bfhi(xx.w);
            bv[0] = bflo(bb.x); bv[1] = bfhi(bb.x); bv[2] = bflo(bb.y); bv[3] = bfhi(bb.y); bv[4] = bflo(bb.z); bv[5] = bfhi(bb.z); bv[6] = bflo(bb.w); bv[7] = bfhi(bb.w);
#pragma unroll
            for (int i = 0; i < 8; ++i) { y[i] = bv[i] * (w0[i] * c2[i] + w1[i] * c1[i] + w2[i] * c0[i]); c2[i] = c1[i]; c1[i] = c0[i]; }
            u32x4 w; w.x = pk2(y[0], y[1]); w.y = pk2(y[2], y[3]); w.z = pk2(y[4], y[5]); w.w = pk2(y[6], y[7]);
            *(u32x4*)yp = w;
        }
    }
}


typedef float f32x16 __attribute__((ext_vector_type(16)));

template <bool MASKED>
__device__ __forceinline__ void attn_weights(const f32x16 (&st)[2], int s0, int tq, int h, float& run, unsigned (&wp)[2][8]) {
#pragma unroll
    for (int kt = 1; kt >= 0; --kt) {
        float lkv[16], zz[16], T[4], Tp[4];
#pragma unroll
        for (int i = 0; i < 16; ++i) { const float y = st[kt][i] * 1.4426950408889634f;
            const float sp = fmaxf(y, 0.f) + __builtin_amdgcn_logf(1.f + __builtin_amdgcn_exp2f(-fabsf(y)));
            if (MASKED) { const bool valid = (s0 + 32 * kt + (i & 3) + 8 * (i >> 2) + 4 * h) < tq; lkv[i] = valid ? -sp : 0.f; zz[i] = valid ? y - sp : -INFINITY; }
            else { lkv[i] = -sp; zz[i] = y - sp; } }
#pragma unroll
        for (int gq = 0; gq < 4; ++gq) { T[gq] = (lkv[4 * gq] + lkv[4 * gq + 1]) + (lkv[4 * gq + 2] + lkv[4 * gq + 3]); Tp[gq] = __shfl_xor(T[gq], 32); }
        float later = run;
#pragma unroll
        for (int gq = 3; gq >= 0; --gq) {
            const float r3 = later + (h == 0 ? Tp[gq] : 0.f), r2 = r3 + lkv[4 * gq + 3], r1 = r2 + lkv[4 * gq + 2], r0 = r1 + lkv[4 * gq + 1];
            const float w0 = __builtin_amdgcn_exp2f(zz[4 * gq + 0] + r0), w1 = __builtin_amdgcn_exp2f(zz[4 * gq + 1] + r1), w2 = __builtin_amdgcn_exp2f(zz[4 * gq + 2] + r2), w3 = __builtin_amdgcn_exp2f(zz[4 * gq + 3] + r3);
            wp[kt][2 * gq] = pk2(w0, w1); wp[kt][2 * gq + 1] = pk2(w2, w3);
            later += T[gq] + Tp[gq];
        }
        run = later;
    }
}
__device__ __forceinline__ void attn_mfma_unit(bf16_t* P, int unit, LAS unsigned char* wl, int lane) {
    const int qt = unit & 511, hh = (unit >> 9) & 3, b = unit >> 11;
    bf16_t* Yb = P + Y_OFF + (size_t)b * SEQ * YP; const bf16_t* Qb = P + Q_OFF + (size_t)b * SEQ * QP;
    const int q0 = qt * 32, c = lane & 31, h = lane >> 5, tq = q0 + c;
    bf16x8 qf[4];
    { const bf16_t* qp = Yb + (size_t)tq * YP + YC_B + hh * 64 + 8 * h;
#pragma unroll
      for (int ks = 0; ks < 4; ++ks) { const u32x4 w = *(const u32x4*)(qp + 16 * ks); u32x4 o;
          o.x = pk2(bflo(w.x) * 0.125f, bfhi(w.x) * 0.125f); o.y = pk2(bflo(w.y) * 0.125f, bfhi(w.y) * 0.125f);
          o.z = pk2(bflo(w.z) * 0.125f, bfhi(w.z) * 0.125f); o.w = pk2(bflo(w.w) * 0.125f, bfhi(w.w) * 0.125f);
          qf[ks] = __builtin_bit_cast(bf16x8, o); } }
    f32x16 zacc[2];
#pragma unroll
    for (int i = 0; i < 16; ++i) { zacc[0][i] = 0.f; zacc[1][i] = 0.f; }
    float R = 0.f;
    for (int kb = q0 >> 6; kb >= 0; --kb) {
        const int s0 = kb * 64;
        u32x4 vv[8];
        { const u32x4* vrow = (const u32x4*)(Qb + (size_t)(s0 + lane) * QP + QC_V + hh * 64);
#pragma unroll
          for (int i = 0; i < 8; ++i) vv[i] = vrow[i]; }
        bf16x8 kf[2][4];
        { const bf16_t* kp = Qb + (size_t)(s0 + c) * QP + QC_K + hh * 64 + 8 * h;
#pragma unroll
          for (int kt = 0; kt < 2; ++kt)
#pragma unroll
              for (int ks = 0; ks < 4; ++ks) kf[kt][ks] = *(const bf16x8*)(kp + (size_t)32 * kt * QP + 16 * ks); }
        f32x16 st[2];
#pragma unroll
        for (int kt = 0; kt < 2; ++kt) {
#pragma unroll
            for (int i = 0; i < 16; ++i) st[kt][i] = 0.f;
#pragma unroll
            for (int ks = 0; ks < 4; ++ks) st[kt] = __builtin_amdgcn_mfma_f32_32x32x16_bf16(kf[kt][ks], qf[ks], st[kt], 0, 0, 0);
        }
#pragma unroll
        for (int i = 0; i < 8; ++i) { const u32x4 w = vv[i]; LAS unsigned char* base = wl + (8 * i) * 136 + lane * 2;
            *(LAS unsigned short*)(base + 0 * 136) = (unsigned short)(w.x & 0xffffu); *(LAS unsigned short*)(base + 1 * 136) = (unsigned short)(w.x >> 16);
            *(LAS unsigned short*)(base + 2 * 136) = (unsigned short)(w.y & 0xffffu); *(LAS unsigned short*)(base + 3 * 136) = (unsigned short)(w.y >> 16);
            *(LAS unsigned short*)(base + 4 * 136) = (unsigned short)(w.z & 0xffffu); *(LAS unsigned short*)(base + 5 * 136) = (unsigned short)(w.z >> 16);
            *(LAS unsigned short*)(base + 6 * 136) = (unsigned short)(w.w & 0xffffu); *(LAS unsigned short*)(base + 7 * 136) = (unsigned short)(w.w >> 16); }
        unsigned wp[2][8];
        float run = R;
        if (kb == (q0 >> 6)) attn_weights<true>(st, s0, tq, h, run, wp); else attn_weights<false>(st, s0, tq, h, run, wp);
        R = run;
        LDS_WAIT();
#pragma unroll
        for (int kt = 0; kt < 2; ++kt)
#pragma unroll
            for (int s2 = 0; s2 < 2; ++s2) {
                u32x4 af; af.x = wp[kt][4 * s2 + 0]; af.y = wp[kt][4 * s2 + 1]; af.z = wp[kt][4 * s2 + 2]; af.w = wp[kt][4 * s2 + 3];
                const bf16x8 afrag = __builtin_bit_cast(bf16x8, af);
#pragma unroll
                for (int dt = 0; dt < 2; ++dt) {
                    const LAS unsigned char* vp = wl + (c + 32 * dt) * 136 + (32 * kt + 16 * s2 + 4 * h) * 2;
                    const u32x2 lo = *(const LAS u32x2*)vp, hi = *(const LAS u32x2*)(vp + 16);
                    u32x4 bfv; bfv.x = lo.x; bfv.y = lo.y; bfv.z = hi.x; bfv.w = hi.y;
                    zacc[dt] = __builtin_amdgcn_mfma_f32_32x32x16_bf16(afrag, __builtin_bit_cast(bf16x8, bfv), zacc[dt], 0, 0, 0);
                }
            }
        LDS_WAIT();
        if (__all(R < -150.1f)) break;
    }
#pragma unroll
    for (int dt = 0; dt < 2; ++dt)
#pragma unroll
        for (int i = 0; i < 16; ++i) Yb[(size_t)(q0 + (i & 3) + 8 * (i >> 2) + 4 * h) * YP + YC_B + hh * 64 + c + 32 * dt] = (bf16_t)f2bf(zacc[dt][i]);
}


constexpr int L_XT = 0, L_BN = 69632, L_CN = 87040, L_BT = 104448, L_ACS = 121856, L_DTV = 123904, L_ATAB = 125952, L_SS = 128000, L_NW = 130048;
template <bool OUT>
__device__ __forceinline__ void ssd2_stage(KA a, int l, const bf16_t* Qb, int b, int t0, LAS unsigned char* lds, int tid) {
    const float* cw = a->in[IN_SSMCW] + (size_t)l * 4 * 768; const float* cbias = a->in[IN_SSMCB] + (size_t)l * 768;
    const int lane = tid & 63, wave = tid >> 6;
    {
        const int ch = tid; const bf16_t* col = Qb + (size_t)t0 * QP + QC_XBC + ch;
        const float w0 = cw[ch], w1 = cw[768 + ch], w2 = cw[1536 + ch], w3 = cw[2304 + ch], bs = cbias[ch];
        float r1 = 0.f, r2 = 0.f, r3 = 0.f;
        if (t0 > 0) { r1 = bf2f(*(col - (size_t)QP)); r2 = bf2f(*(col - (size_t)2 * QP)); r3 = bf2f(*(col - (size_t)3 * QP)); }
        LAS unsigned char* dst = lds + L_XT + ch * 136;
#pragma unroll 4
        for (int s0 = 0; s0 < 64; s0 += 8) {
            bf16_t raw[8]; float v[8];
#pragma unroll
            for (int j = 0; j < 8; ++j) raw[j] = col[(size_t)(s0 + j) * QP];
#pragma unroll
            for (int j = 0; j < 8; ++j) { const float r0 = bf2f(raw[j]); v[j] = siluf_(w0 * r3 + w1 * r2 + w2 * r1 + w3 * r0 + bs); r3 = r2; r2 = r1; r1 = r0; }
            u32x2 o0, o1; o0.x = pk2(v[0], v[1]); o0.y = pk2(v[2], v[3]); o1.x = pk2(v[4], v[5]); o1.y = pk2(v[6], v[7]);
            *(LAS u32x2*)(dst + s0 * 2) = o0; *(LAS u32x2*)(dst + s0 * 2 + 8) = o1;
        }
    }
    {
        constexpr int NCH = OUT ? 256 : 128, PARTS = NTHREADS / NCH, RPP = 64 / PARTS;
        const int ch2 = tid % NCH, rs = (tid / NCH) * RPP;
        const bf16_t* col = Qb + (size_t)(t0 + rs) * QP + QC_XBC + 512 + ch2;
        const float w0 = cw[512 + ch2], w1 = cw[768 + 512 + ch2], w2 = cw[1536 + 512 + ch2], w3 = cw[2304 + 512 + ch2], bs = cbias[512 + ch2];
        float r1 = 0.f, r2 = 0.f, r3 = 0.f;
        if (t0 + rs > 0) { r1 = bf2f(*(col - (size_t)QP)); r2 = bf2f(*(col - (size_t)2 * QP)); r3 = bf2f(*(col - (size_t)3 * QP)); }
        const bool isB = ch2 < 128;
        LAS unsigned char* nat = lds + (isB ? L_BN + ch2 * 2 : L_CN + (ch2 - 128) * 2) + rs * 272;
        LAS unsigned char* tr = lds + L_BT + ch2 * 136 + rs * 2;
#pragma unroll
        for (int s0 = 0; s0 < RPP; s0 += 8) {
            bf16_t raw[8]; float v[8];
#pragma unroll
            for (int j = 0; j < 8; ++j) raw[j] = col[(size_t)(s0 + j) * QP];
#pragma unroll
            for (int j = 0; j < 8; ++j) { const float r0 = bf2f(raw[j]); v[j] = siluf_(w0 * r3 + w1 * r2 + w2 * r1 + w3 * r0 + bs); r3 = r2; r2 = r1; r1 = r0; }
            if (OUT) {
#pragma unroll
                for (int j = 0; j < 8; ++j) *(LAS unsigned short*)(nat + (s0 + j) * 272) = (unsigned short)f2bf(v[j]);
            } else {
                u32x2 o0, o1; o0.x = pk2(v[0], v[1]); o0.y = pk2(v[2], v[3]); o1.x = pk2(v[4], v[5]); o1.y = pk2(v[6], v[7]);
                *(LAS u32x2*)(tr + s0 * 2) = o0; *(LAS u32x2*)(tr + s0 * 2 + 8) = o1;
            }
        }
    }
    {
        const int r = tid >> 3, hh = tid & 7;
        const float dtr = ((const float*)(a->ws + WS_DT))[(size_t)(b * SEQ + t0 + r) * 8 + hh] + a->in[IN_DTB][l * 8 + hh];
        const float dtv = softplusf_(dtr);
        ((LAS float*)(lds + L_DTV))[r * 8 + hh] = dtv; ((LAS float*)(lds + L_ATAB))[hh * 64 + r] = -dtv * __expf(a->in[IN_ALOG][l * 8 + hh]);
    }
    if (OUT) ((LAS float*)(lds + L_NW))[tid] = a->in[IN_SSMNW][(size_t)l * 512 + tid];
    __syncthreads();
    {
        float v = ((LAS float*)(lds + L_ATAB))[wave * 64 + lane];
#pragma unroll
        for (int o = 1; o < 64; o <<= 1) { const float u = __shfl_up(v, o); if (lane >= o) v += u; }
        ((LAS float*)(lds + L_ACS))[lane * 8 + wave] = v;
    }
    __syncthreads();
}
__device__ __forceinline__ bf16x8 rd2x64(const LAS unsigned char* p) { const u32x2 lo = *(const LAS u32x2*)p, hi = *(const LAS u32x2*)(p + 8); u32x4 v; v.x = lo.x; v.y = lo.y; v.z = hi.x; v.w = hi.y; return __builtin_bit_cast(bf16x8, v); }
__device__ __forceinline__ bf16x8 rd2x64_gap(const LAS unsigned char* p) { const u32x2 lo = *(const LAS u32x2*)p, hi = *(const LAS u32x2*)(p + 16); u32x4 v; v.x = lo.x; v.y = lo.y; v.z = hi.x; v.w = hi.y; return __builtin_bit_cast(bf16x8, v); }

__device__ __forceinline__ void ssd2_pass1(KA a, int l, bf16_t* P, int unit, LAS unsigned char* lds, int tid) {
    const int b = unit / SSD_NCH, ck = unit % SSD_NCH, t0 = ck * SSD_CH;
    const bf16_t* Qb = P + Q_OFF + (size_t)b * SEQ * QP;
    ssd2_stage<false>(a, l, Qb, b, t0, lds, tid);
    const int lane = tid & 63, h = __builtin_amdgcn_readfirstlane(tid >> 6), g = h >> 2, c = lane & 31, hh = lane >> 5;
    const LAS float* ACS = (const LAS float*)(lds + L_ACS); const LAS float* DTV = (const LAS float*)(lds + L_DTV);
    const float acs_end = ACS[63 * 8 + h];
    f32x16 sacc[2][2];
#pragma unroll
    for (int i = 0; i < 16; ++i) { sacc[0][0][i] = 0.f; sacc[0][1][i] = 0.f; sacc[1][0][i] = 0.f; sacc[1][1][i] = 0.f; }
#pragma unroll
    for (int ks = 0; ks < 4; ++ks) {
        float wg[8];
#pragma unroll
        for (int j = 0; j < 8; ++j) { const int s = 16 * ks + 8 * hh + j; wg[j] = DTV[s * 8 + h] * __expf(acs_end - ACS[s * 8 + h]); }
        bf16x8 bfr[2];
#pragma unroll
        for (int nt = 0; nt < 2; ++nt) bfr[nt] = rd2x64(lds + L_BT + (g * 64 + c + 32 * nt) * 136 + (16 * ks + 8 * hh) * 2);
#pragma unroll
        for (int pt = 0; pt < 2; ++pt) {
            const LAS unsigned char* xp = lds + L_XT + (h * 64 + c + 32 * pt) * 136 + (16 * ks + 8 * hh) * 2;
            const u32x2 lo = *(const LAS u32x2*)xp, hi = *(const LAS u32x2*)(xp + 8);
            u32x4 o; o.x = pk2(bflo(lo.x) * wg[0], bfhi(lo.x) * wg[1]); o.y = pk2(bflo(lo.y) * wg[2], bfhi(lo.y) * wg[3]);
            o.z = pk2(bflo(hi.x) * wg[4], bfhi(hi.x) * wg[5]); o.w = pk2(bflo(hi.y) * wg[6], bfhi(hi.y) * wg[7]);
            const bf16x8 afr = __builtin_bit_cast(bf16x8, o);
#pragma unroll
            for (int nt = 0; nt < 2; ++nt) sacc[pt][nt] = __builtin_amdgcn_mfma_f32_32x32x16_bf16(afr, bfr[nt], sacc[pt][nt], 0, 0, 0);
        }
    }
    bf16_t* stp = (bf16_t*)(a->ws + WS_HM) + ((size_t)(b * SSD_NCH + ck) * 8 + h) * 4096;
#pragma unroll
    for (int pt = 0; pt < 2; ++pt)
#pragma unroll
        for (int nt = 0; nt < 2; ++nt)
#pragma unroll
            for (int i = 0; i < 16; ++i) stp[(32 * pt + (i & 3) + 8 * (i >> 2) + 4 * hh) * 64 + c + 32 * nt] = (bf16_t)f2bf(sacc[pt][nt][i]);
    if (lane == 0) ((float*)(a->ws + WS_CD))[(size_t)(b * SSD_NCH + ck) * 8 + h] = acs_end;
    __syncthreads();
}

__device__ __forceinline__ void ssd2_pass3(KA a, int l, bf16_t* P, int unit, LAS unsigned char* lds, int tid) {
    const int b = unit / SSD_NCH, ck = unit % SSD_NCH, t0 = ck * SSD_CH;
    bf16_t* Yb = P + Y_OFF + (size_t)b * SEQ * YP; const bf16_t* Qb = P + Q_OFF + (size_t)b * SEQ * QP;
    ssd2_stage<true>(a, l, Qb, b, t0, lds, tid);
    const int lane = tid & 63, h = __builtin_amdgcn_readfirstlane(tid >> 6), g = h >> 2, c = lane & 31, hh = lane >> 5;
    const LAS float* ACS = (const LAS float*)(lds + L_ACS); const LAS float* DTV = (const LAS float*)(lds + L_DTV);
    LAS float* SS = (LAS float*)(lds + L_SS); const LAS float* NW = (const LAS float*)(lds + L_NW);
    f32x16 acc[2][2];
    const float Dh = a->in[IN_SSMD][l * 8 + h];
    const bf16_t* prev = (const bf16_t*)(a->ws + WS_HM) + ((size_t)(b * SSD_NCH + ck) * 8 + h) * 4096;
#pragma unroll
    for (int tt = 0; tt < 2; ++tt) {
        asm volatile("" ::: "memory"); __builtin_amdgcn_sched_barrier(0);
        const int t = c + 32 * tt;
        const float acs_t = ACS[t * 8 + h];
        bf16x8 cfr[4];
#pragma unroll
        for (int ks = 0; ks < 4; ++ks) cfr[ks] = *(const LAS bf16x8*)(lds + L_CN + t * 272 + (g * 64 + 16 * ks + 8 * hh) * 2);
#pragma unroll
        for (int i = 0; i < 16; ++i) { acc[0][tt][i] = 0.f; acc[1][tt][i] = 0.f; }
#pragma unroll
        for (int st = 0; st <= tt; ++st) {
            f32x16 gm;
#pragma unroll
            for (int i = 0; i < 16; ++i) gm[i] = 0.f;
#pragma unroll
            for (int ks = 0; ks < 4; ++ks) {
                const bf16x8 bfr = *(const LAS bf16x8*)(lds + L_BN + (c + 32 * st) * 272 + (g * 64 + 16 * ks + 8 * hh) * 2);
                gm = __builtin_amdgcn_mfma_f32_32x32x16_bf16(bfr, cfr[ks], gm, 0, 0, 0);
            }
            unsigned wp[8];
#pragma unroll
            for (int i2 = 0; i2 < 8; ++i2) {
                float w2[2];
#pragma unroll
                for (int e = 0; e < 2; ++e) { const int i = 2 * i2 + e; const int sx = 32 * st + (i & 3) + 8 * (i >> 2) + 4 * hh;
                    const float v = gm[i] * __expf(acs_t - ACS[sx * 8 + h]) * DTV[sx * 8 + h];
                    w2[e] = (sx <= t) ? v : 0.f; }
                wp[i2] = pk2(w2[0], w2[1]);
            }
#pragma unroll
            for (int s2 = 0; s2 < 2; ++s2) {
                u32x4 wv; wv.x = wp[4 * s2]; wv.y = wp[4 * s2 + 1]; wv.z = wp[4 * s2 + 2]; wv.w = wp[4 * s2 + 3];
                const bf16x8 wfr = __builtin_bit_cast(bf16x8, wv);
#pragma unroll
                for (int pt = 0; pt < 2; ++pt) {
                    const bf16x8 xfr = rd2x64_gap(lds + L_XT + (h * 64 + c + 32 * pt) * 136 + (32 * st + 16 * s2 + 4 * hh) * 2);
                    acc[pt][tt] = __builtin_amdgcn_mfma_f32_32x32x16_bf16(xfr, wfr, acc[pt][tt], 0, 0, 0);
                }
            }
        }
        {
            const float et = __expf(acs_t);
#pragma unroll
            for (int ks = 0; ks < 4; ++ks) {
                const u32x4 cv = __builtin_bit_cast(u32x4, cfr[ks]); u32x4 o;
                o.x = pk2(bflo(cv.x) * et, bfhi(cv.x) * et); o.y = pk2(bflo(cv.y) * et, bfhi(cv.y) * et); o.z = pk2(bflo(cv.z) * et, bfhi(cv.z) * et); o.w = pk2(bflo(cv.w) * et, bfhi(cv.w) * et);
                const bf16x8 cs = __builtin_bit_cast(bf16x8, o);
#pragma unroll
                for (int pt = 0; pt < 2; ++pt) {
                    const bf16x8 pfr = *(const bf16x8*)(prev + (c + 32 * pt) * 64 + 16 * ks + 8 * hh);
                    acc[pt][tt] = __builtin_amdgcn_mfma_f32_32x32x16_bf16(pfr, cs, acc[pt][tt], 0, 0, 0);
                }
            }
        }
        const u32x4* zrow = (const u32x4*)(Yb + (size_t)(t0 + t) * YP + YC_C + h * 64);
        float ss = 0.f;
#pragma unroll
        for (int pt = 0; pt < 2; ++pt)
#pragma unroll
            for (int q = 0; q < 4; ++q) {
                const u32x4 zr = zrow[4 * pt + q];
                const unsigned zlo = hh ? zr.z : zr.x, zhi = hh ? zr.w : zr.y;
                const float zv[4] = {bflo(zlo), bfhi(zlo), bflo(zhi), bfhi(zhi)};
#pragma unroll
                for (int r = 0; r < 4; ++r) { const int i = 4 * q + r, p = 32 * pt + 8 * q + 4 * hh + r;
                    const float xv = bf2f(*(const LAS unsigned short*)(lds + L_XT + (h * 64 + p) * 136 + t * 2));
                    const float yz = (acc[pt][tt][i] + Dh * xv) * siluf_(zv[r]);
                    acc[pt][tt][i] = yz; ss += yz * yz; }
            }
        ss += __shfl_xor(ss, 32);
        if (hh == 0) SS[t * 8 + h] = ss;
    }
    __syncthreads();
#pragma unroll
    for (int tt = 0; tt < 2; ++tt) {
        const int t = c + 32 * tt;
        const float tot = (SS[t * 8 + g * 4 + 0] + SS[t * 8 + g * 4 + 1]) + (SS[t * 8 + g * 4 + 2] + SS[t * 8 + g * 4 + 3]);
        const float rs = 1.0f / sqrtf(tot * (1.f / 256.f) + EPS);
        bf16_t* orow = Yb + (size_t)(t0 + t) * YP + YC_C + h * 64;
#pragma unroll
        for (int pt = 0; pt < 2; ++pt)
#pragma unroll
            for (int q = 0; q < 4; ++q) { const int p0 = 32 * pt + 8 * q + 4 * hh; const f32x4 nw = *(const LAS f32x4*)(NW + h * 64 + p0);
                u32x2 o; o.x = pk2(acc[pt][tt][4 * q + 0] * rs * nw[0], acc[pt][tt][4 * q + 1] * rs * nw[1]); o.y = pk2(acc[pt][tt][4 * q + 2] * rs * nw[2], acc[pt][tt][4 * q + 3] * rs * nw[3]);
                *(u32x2*)(orow + p0) = o; }
    }
    __syncthreads();
}
__device__ __forceinline__ void ssd2_scan_phase(KA a, int tid) {
    bf16_t* STATES = (bf16_t*)(a->ws + WS_HM); const float* CDp = (const float*)(a->ws + WS_CD);
    for (int it = blockIdx.x * NTHREADS + tid; it < BATCH * 8 * 4096; it += gridDim.x * NTHREADS) {
        const int e = it & 4095, bh = it >> 12, b = bh >> 3, h = bh & 7;
        float run = 0.f;
#pragma unroll 32
        for (int cc = 0; cc < SSD_NCH; ++cc) {
            bf16_t* p = STATES + ((size_t)(b * SSD_NCH + cc) * 8 + h) * 4096 + e;
            const float sv = bf2f(*p); const float dec = __expf(CDp[(size_t)(b * SSD_NCH + cc) * 8 + h]);
            *p = (bf16_t)f2bf(run); run = run * dec + sv;
        }
    }
}

#define XB_TMO      128
#define XB_XCNT(j)  (256  + 64 * (j))
#define XB_XSUB(j)  (1280 + 64 * (j))
#define XB_XGEN(j)  (2304 + 64 * (j))
#define XB_TOP      3328
#define XB_TOPGEN   3392
#define XCD_BAR_WORDS 3456
#define XB_SPIN_CAP (1u << 22)
__device__ __forceinline__ unsigned xb_ld(unsigned* p)              { return __hip_atomic_load(p, __ATOMIC_RELAXED, __HIP_MEMORY_SCOPE_AGENT); }
__device__ __forceinline__ unsigned xb_add(unsigned* p, unsigned v) { return __hip_atomic_fetch_add(p, v, __ATOMIC_RELAXED, __HIP_MEMORY_SCOPE_AGENT); }
__device__ __forceinline__ unsigned xb_xcc_id() { return (unsigned)__builtin_amdgcn_s_getreg((3 << 11) | 20) & 0xFu; }
#define XB_SPIN(cond, bar) do { unsigned _sp = 0; while (cond) { __builtin_amdgcn_s_sleep(1); \
    if ((++_sp & 255u) == 0u) { if (xb_ld(&(bar)[XB_TMO])) break; if (_sp > XB_SPIN_CAP) { atomicAdd(&(bar)[XB_TMO], 1u); break; } } } } while (0)
struct XcdBarrier { unsigned* bar; unsigned x; volatile LAS unsigned* st; };
__device__ __forceinline__ XcdBarrier xcd_barrier_post(unsigned* bar, volatile LAS unsigned* st) {
    XcdBarrier b; b.bar = bar; b.x = xb_xcc_id(); b.st = st;
    if (threadIdx.x == 0) (void)xb_add(&bar[XB_XCNT(b.x)], 1u);
    return b;
}
__device__ __forceinline__ void xcd_barrier_complete(unsigned* bar, unsigned x, unsigned& nloc, unsigned& nx) {
    const unsigned G = gridDim.x * gridDim.y * gridDim.z;
    unsigned sum, cnt, mine, sp = 0u;
    for (;;) {
        sum = 0u; cnt = 0u; mine = 0u;
#pragma unroll 1
        for (unsigned j = 0; j < 16; ++j) { const unsigned c = xb_ld(&bar[XB_XCNT(j)]); sum += c; cnt += (c > 0u) ? 1u : 0u; mine = (j == x) ? c : mine; }
        if (sum == G) break;
        __builtin_amdgcn_s_sleep(1);
        if ((++sp & 255u) == 0u) { if (xb_ld(&bar[XB_TMO])) break; if (sp > XB_SPIN_CAP) { atomicAdd(&bar[XB_TMO], 1u); break; } }
    }
    nloc = mine > 0u ? mine : 1u; nx = cnt > 0u ? cnt : 1u;
}
__device__ __forceinline__ void xcd_barrier(const XcdBarrier& b) {
    asm volatile("s_waitcnt vmcnt(0)" ::: "memory");
    __syncthreads();
    if (threadIdx.x == 0) {
        unsigned* bar = b.bar;
        __builtin_amdgcn_s_waitcnt(0);
        unsigned nloc = b.st[0], nx = b.st[1];
        if (nloc == 0u) { xcd_barrier_complete(bar, b.x, nloc, nx); b.st[0] = nloc; b.st[1] = nx; }
        const unsigned old = xb_add(&bar[XB_XSUB(b.x)], 1u);
        const unsigned gen = old / nloc;
        if (old + 1u == (gen + 1u) * nloc) {
            __builtin_amdgcn_fence(__ATOMIC_RELEASE, "agent");
            asm volatile("s_waitcnt vmcnt(0)" ::: "memory");
            const unsigned og = xb_add(&bar[XB_TOP], 1u);
            const unsigned tg = og / nx;
            if (og + 1u == (tg + 1u) * nx) xb_add(&bar[XB_TOPGEN], 1u);
            else XB_SPIN(xb_ld(&bar[XB_TOPGEN]) == tg, bar);
            __builtin_amdgcn_fence(__ATOMIC_ACQUIRE, "agent");
            xb_add(&bar[XB_XGEN(b.x)], 1u);
            asm volatile("s_waitcnt vmcnt(0)" ::: "memory");
        } else {
            XB_SPIN(xb_ld(&bar[XB_XGEN(b.x)]) == gen, bar);
            __builtin_amdgcn_fence(__ATOMIC_ACQUIRE, "agent");
            asm volatile("s_waitcnt vmcnt(0)" ::: "memory");
        }
    }
    __syncthreads();
}

constexpr int PH_PER_LAYER = 11;

#define SEAM(k) xcd_barrier(xbar)
template <int l>
__device__ __forceinline__ void layer_phases(LAS unsigned char* lds, const XcdBarrier xbar, cg::grid_group& grid, const int wave, const int G, const int bx, const int gw, const int NGW) {
    const int pb = 1 + l * PH_PER_LAYER; int tid, lane;
        if (l == 0) {
            {
                KA ka = ka_fresh(); tid = threadIdx.x; asm volatile("" : "+v"(tid)); lane = tid & 63; unsigned char* ws = ka->ws; bf16_t* HM = (bf16_t*)(ws + WS_HM); const float* modl = (const float*)(ws + WS_MOD) + (size_t)l * 2 * 6144;
                const float* xcur = ka->in[IN_X]; const float* gpm = ka->in[IN_GPM] + (size_t)l * D;
                for (int m = gw; m < M; m += NGW) { const int b = m / SEQ; const float* md = modl + (size_t)b * 6144;
                    prenorm_row(xcur + (size_t)m * D, gpm, md + 1024, md + 0, HM + (size_t)m * D, lane); }
            }
            SEAM(pb + 0);
        }
        {
            KA ka = ka_fresh(); tid = threadIdx.x; asm volatile("" : "+v"(tid)); lane = tid & 63; unsigned char* ws = ka->ws; unsigned char* wl = ws + WS_W + (size_t)l * W_LAYER;
            pg8::Gemm g{(const bf16_t*)(ws + WS_HM), (const bf16_t*)(wl + W_IN), M, NPAD, D, D, D}; pg8::StaticOrder S; S.init(M, NPAD, G, bx);
            pg8::EpiProj E{(bf16_t*)(ws + WS_P), (float*)(ws + WS_DT)};
            pg8::gemm_phase<pg8::EpiProj>(lds, g, S, E);
        }
        SEAM(pb + 1);
        {
            KA ka = ka_fresh(); tid = threadIdx.x; asm volatile("" : "+v"(tid)); lane = tid & 63; bf16_t* P = (bf16_t*)(ka->ws + WS_P);
            for (int u = bx; u < BATCH * SSD_NCH; u += G) ssd2_pass1(ka, l, P, u, lds, tid);
            __syncthreads();
            tid = threadIdx.x; asm volatile("" : "+v"(tid)); lane = tid & 63;
            for (int u = gw; u < BATCH * 4 * 512; u += NGW) attn_mfma_unit(P, u, lds + wave * 16384, lane);
            tid = threadIdx.x; asm volatile("" : "+v"(tid)); lane = tid & 63;
            if (G < 2) shortconv_phase(ka, l, P, tid, bx, G);
        }
        SEAM(pb + 2);
        { KA ka = ka_fresh(); tid = threadIdx.x; asm volatile("" : "+v"(tid)); lane = tid & 63; ssd2_scan_phase(ka, tid);
            if (l == 0 && G >= 2) {
                const int nscan = (BATCH * 8 * 4096) / NTHREADS < G ? (BATCH * 8 * 4096) / NTHREADS : 0;
                if (bx >= nscan) { LAS float* scr = (LAS float*)(lds + wave * 16384);
                    for (int it = (bx - nscan) * NWAVES + wave; it < TR_PER_LAYER; it += (G - nscan) * NWAVES) tr_dispatch(ka, TR_PER_LAYER + it, scr, lane); } }
            if (G >= 2) {
                const int nscan = (BATCH * 8 * 4096) / NTHREADS < G ? (BATCH * 8 * 4096) / NTHREADS : 0;
                if (nscan == 0) shortconv_phase(ka, l, (bf16_t*)(ka->ws + WS_P), tid, bx, G); else if (bx >= nscan) shortconv_phase(ka, l, (bf16_t*)(ka->ws + WS_P), tid, bx - nscan, G - nscan); } }
        SEAM(pb + 3);
        { KA ka = ka_fresh(); tid = threadIdx.x; asm volatile("" : "+v"(tid)); lane = tid & 63; bf16_t* P = (bf16_t*)(ka->ws + WS_P); for (int u = bx; u < BATCH * SSD_NCH; u += G) ssd2_pass3(ka, l, P, u, lds, tid); }
        SEAM(pb + 4);
        {
            KA ka = ka_fresh(); tid = threadIdx.x; asm volatile("" : "+v"(tid)); lane = tid & 63; unsigned char* ws = ka->ws; unsigned char* wl = ws + WS_W + (size_t)l * W_LAYER; bf16_t* P = (bf16_t*)(ws + WS_P);
            pg8::Gemm g{P + Y_OFF, (const bf16_t*)(wl + W_OUT3), M, D, D, YP, D}; pg8::StaticOrder S; S.init(M, D, G, bx);
            pg8::EpiGate3 E{(bf16_t*)(ws + WS_HM), P + G_OFF};
            pg8::gemm_phase<pg8::EpiGate3>(lds, g, S, E);
        }
        SEAM(pb + 5);
        {
            KA ka = ka_fresh(); tid = threadIdx.x; asm volatile("" : "+v"(tid)); lane = tid & 63; unsigned char* ws = ka->ws; unsigned char* wl = ws + WS_W + (size_t)l * W_LAYER;
            pg8::Gemm g{(const bf16_t*)(ws + WS_HM), (const bf16_t*)(wl + W_O), M, D, D, D, D}; pg8::StaticOrder S; S.init(M, D, G, bx);
            const float* modl = (const float*)(ws + WS_MOD) + (size_t)l * 2 * 6144;
            pg8::EpiResNorm<(l != 0), true> E{(l == 0) ? (const void*)ka->in[IN_X] : (const void*)ka->out, (void*)(ws + WS_P), modl + 2048, ka->in[IN_GPOM] + (size_t)l * D, 1, ka->in[IN_GPF] + (size_t)l * D, modl + 4096, modl + 3072,
                              (bf16_t*)(ws + WS_P + P_H2),
                              pg8::PanelSq{(float*)(ws + WS_XBUF) + (size_t)(l * 4 + 0) * 131072, (unsigned*)(ws + WS_PCNT), 32u * (unsigned)(l * 4 + 1)},
                              pg8::PanelSq{(float*)(ws + WS_XBUF) + (size_t)(l * 4 + 1) * 131072, (unsigned*)(ws + WS_PCNT), 32u * (unsigned)(l * 4 + 2)}};
            pg8::gemm_phase<pg8::EpiResNorm<(l != 0), true>>(lds, g, S, E);
        }
        SEAM(pb + 6);
        {
            KA ka = ka_fresh(); tid = threadIdx.x; asm volatile("" : "+v"(tid)); lane = tid & 63; unsigned char* ws = ka->ws; unsigned char* wl = ws + WS_W + (size_t)l * W_LAYER;
            pg8::Gemm g{(const bf16_t*)(ws + WS_P + P_H2), (const bf16_t*)(wl + W_FI), M, 2 * FFN, D, D, D}; pg8::StaticOrder S; S.init(M, 2 * FFN, G, bx);
            pg8::EpiSwiGLU E{(bf16_t*)(ws + WS_P + P_ACT)};
            pg8::gemm_phase<pg8::EpiSwiGLU>(lds, g, S, E);
        }
        SEAM(pb + 8);
        {
            KA ka = ka_fresh(); tid = threadIdx.x; asm volatile("" : "+v"(tid)); lane = tid & 63; unsigned char* ws = ka->ws; unsigned char* wl = ws + WS_W + (size_t)l * W_LAYER;
            pg8::Gemm g{(const bf16_t*)(ws + WS_P + P_ACT), (const bf16_t*)(wl + W_FO), M, D, FFN, FFN, FFN}; pg8::StaticOrder S; S.init(M, D, G, bx);
            constexpr bool nxt = (l + 1 < DEPTH); constexpr int ln = nxt ? l + 1 : l;
            const float* modl = (const float*)(ws + WS_MOD) + (size_t)l * 2 * 6144; const float* modn = (const float*)(ws + WS_MOD) + (size_t)ln * 2 * 6144;
            pg8::EpiResNorm<true, nxt> E{(const void*)(ws + WS_P), (void*)ka->out, modl + 5120, ka->in[IN_GPOF] + (size_t)l * D, nxt ? 1 : 0, ka->in[IN_GPM] + (size_t)ln * D, modn + 1024, modn + 0,
                              (bf16_t*)(ws + WS_HM),
                              pg8::PanelSq{(float*)(ws + WS_XBUF) + (size_t)(l * 4 + 2) * 131072, (unsigned*)(ws + WS_PCNT), 32u * (unsigned)(l * 4 + 3)},
                              pg8::PanelSq{(float*)(ws + WS_XBUF) + (size_t)(l * 4 + 3) * 131072, (unsigned*)(ws + WS_PCNT), 32u * (unsigned)(l * 4 + 4)}};
            pg8::gemm_phase<pg8::EpiResNorm<true, nxt>>(lds, g, S, E);
        }
        if (l + 1 < DEPTH) SEAM(pb + 9);
}

__global__ void __launch_bounds__(NTHREADS, 2) fwd_kernel(Args args_unused) {
    extern __shared__ __attribute__((aligned(16))) unsigned char lds_raw[];
    LAS unsigned char* lds = (LAS unsigned char*)lds_raw;
    int tid = threadIdx.x; asm volatile("" : "+v"(tid));
    int lane = tid & 63; const int wave = __builtin_amdgcn_readfirstlane(tid >> 6);
    const int G = gridDim.x, bx = blockIdx.x;
    const int gw = bx * NWAVES + wave, NGW = G * NWAVES;
    cg::grid_group grid = cg::this_grid();
    if (tid < 16) ((LAS unsigned*)(lds + LDS_BYTES - 64))[tid] = 0u;
    __syncthreads();
    XcdBarrier xbar; { KA ka = ka_fresh(); xbar = xcd_barrier_post((unsigned*)(ka->ws + WS_BAR), (volatile LAS unsigned*)(lds + LDS_BYTES - 64)); }

    if (gridDim.y == 12345u) grid.sync();
    {
        KA ka = ka_fresh(); tid = threadIdx.x; asm volatile("" : "+v"(tid)); lane = tid & 63;
        for (int it = bx; it < 192; it += G) mod_item(ka, it, (LAS float*)lds, tid);
        LAS float* scr = (LAS float*)(lds + wave * 16384);
        for (int it = gw; it < TR_PER_LAYER; it += NGW) tr_dispatch(ka, it, scr, lane);
    }
    SEAM(0);

    layer_phases<0>(lds, xbar, grid, wave, G, bx, gw, NGW);
    layer_phases<1>(lds, xbar, grid, wave, G, bx, gw, NGW);
#undef SEAM
}

extern "C" void kernel_launch(void* const* d_in, const int* in_sizes, int n_in, void* d_out, int out_size, void* d_ws, size_t ws_size, hipStream_t stream) {
    static int grid = 0;
    if (grid == 0) {
        if (n_in != 22 || out_size != M * D || ws_size < WS_END) { fprintf(stderr, "kernel_launch: unexpected shapes (n_in %d, out %d, ws %zu)\n", n_in, out_size, ws_size); grid = -1; return; }
        int dev = 0, cus = 0, per_cu = 0;
        hipGetDevice(&dev); hipDeviceGetAttribute(&cus, hipDeviceAttributeMultiprocessorCount, dev);
        if (hipFuncSetAttribute((const void*)fwd_kernel, hipFuncAttributeMaxDynamicSharedMemorySize, LDS_BYTES) != hipSuccess) { fprintf(stderr, "kernel_launch: hipFuncSetAttribute failed\n"); grid = -1; return; }
        if (hipOccupancyMaxActiveBlocksPerMultiprocessor(&per_cu, (const void*)fwd_kernel, NTHREADS, LDS_BYTES) != hipSuccess || per_cu < 1) { fprintf(stderr, "kernel_launch: occupancy query says %d\n", per_cu); per_cu = 1; }
        (void)hipGetLastError();
        grid = cus >= 256 ? 256 : cus;
    }
    if (grid < 0) return;
    if (hipMemsetAsync((unsigned char*)d_ws + WS_BAR, 0, 16384 + 32768, stream) != hipSuccess) { fprintf(stderr, "kernel_launch: memset failed\n"); return; }
    Args a{};
    for (int i = 0; i < 22; ++i) a.in[i] = (const float*)d_in[i];
    a.out = (float*)d_out; a.ws = (unsigned char*)d_ws;
    void* kargs[] = {&a};
    hipError_t e = hipLaunchCooperativeKernel((const void*)fwd_kernel, dim3(grid), dim3(NTHREADS), kargs, LDS_BYTES, stream);
    if (e != hipSuccess) fprintf(stderr, "kernel_launch: cooperative launch failed: %s (grid %d)\n", hipGetErrorString(e), grid);
}
```

```cpp
#include <hip/hip_runtime.h>
#include <hip/hip_cooperative_groups.h>
#include <cstdio>
#include <cstdint>
namespace cg = cooperative_groups;

#define LAS __attribute__((address_space(3)))
typedef unsigned short bf16_t;
typedef short bf16x8 __attribute__((ext_vector_type(8)));
typedef float f32x4 __attribute__((ext_vector_type(4)));
typedef float f32x2 __attribute__((ext_vector_type(2)));
typedef unsigned u32x4 __attribute__((ext_vector_type(4)));
typedef unsigned u32x2 __attribute__((ext_vector_type(2)));

constexpr int BATCH = 2, SEQ = 16384, D = 1024, M = BATCH * SEQ, DEPTH = 2;
constexpr int NSRC = 5896;
constexpr int NP = 5888;
constexpr int NPAD = 6144;
constexpr int FFN = 2816;
constexpr float EPS = 1e-6f;
constexpr int YP = 1024, QP = 1792, GP = 3072;
constexpr size_t Y_OFF = 0, Q_OFF = (size_t)M * YP, G_OFF = Q_OFF + (size_t)M * QP;
constexpr int YC_A = 0, YC_B = 256, YC_C = 512, QC_SCC = 0, QC_SCX = 256, QC_K = 512, QC_V = 768, QC_XBC = 1024;
static_assert((G_OFF + (size_t)M * GP) * 2 == (size_t)M * NP * 2, "region size");
constexpr int SSD_CH = 64, SSD_NCH = SEQ / SSD_CH;

constexpr size_t MiB = 1u << 20;
constexpr size_t WS_MOD = 0;
constexpr size_t WS_CD = 128 * 1024;
constexpr size_t WS_BAR = 512 * 1024;
constexpr size_t WS_DT = 1 * MiB;
constexpr size_t WS_W = 2 * MiB;
constexpr size_t W_LAYER = 33 * MiB, W_IN = 0, W_OUT3 = 12 * MiB, W_O = 14 * MiB, W_FI = 16 * MiB, W_FO = 27 * MiB;
constexpr size_t WS_P = 68 * MiB;
constexpr size_t WS_HM = 436 * MiB;
constexpr size_t WS_XBUF = 500 * MiB;
constexpr size_t WS_PCNT = 512 * 1024 + 16384;
constexpr size_t WS_END = 504 * MiB;
constexpr size_t P_H2 = 64 * MiB, P_ACT = 128 * MiB;

enum { IN_X = 0, IN_C, IN_MODW, IN_MODB, IN_GPM, IN_GPOM, IN_GPF, IN_GPOF, IN_WIN, IN_SCW, IN_SSMCW, IN_SSMCB, IN_DTB, IN_ALOG, IN_SSMD, IN_SSMNW, IN_WSC, IN_WSB, IN_WSSM, IN_WO, IN_WFI, IN_WFO };

struct Args { const float* in[22]; float* out; unsigned char* ws; int pad0, pad1; };
typedef const __attribute__((address_space(4))) Args* KA;
__device__ __forceinline__ KA ka_fresh() { KA p = (KA)__builtin_amdgcn_kernarg_segment_ptr(); asm volatile("" : "+s"(p)); return p; }

__device__ __forceinline__ float bf2f(bf16_t v) { return __uint_as_float((unsigned)v << 16); }
__device__ __forceinline__ float bflo(unsigned u) { return __uint_as_float(u << 16); }
__device__ __forceinline__ float bfhi(unsigned u) { return __uint_as_float(u & 0xffff0000u); }
__device__ __forceinline__ unsigned f2bf(float f) { unsigned u = __float_as_uint(f); return (u + 0x7fffu + ((u >> 16) & 1u)) >> 16; }
typedef __bf16 bf16x2_t __attribute__((ext_vector_type(2)));
__device__ __forceinline__ unsigned pk2(float lo, float hi) { f32x2 v = {lo, hi}; const bf16x2_t b = __builtin_convertvector(v, bf16x2_t); return __builtin_bit_cast(unsigned, b); }
__device__ __forceinline__ float wave_sum(float v) {
#pragma unroll
    for (int o = 1; o < 64; o <<= 1) v += __shfl_xor(v, o);
    return v;
}
__device__ __forceinline__ float sigmoidf_(float v) { return __builtin_amdgcn_rcpf(1.f + __expf(-v)); }
__device__ __forceinline__ float siluf_(float v) { return v * sigmoidf_(v); }
__device__ __forceinline__ float softplusf_(float z) { return fmaxf(z, 0.f) + __logf(1.f + __expf(-fabsf(z))); }
#define LDS_WAIT() asm volatile("s_waitcnt lgkmcnt(0)" ::: "memory")

namespace pg8 {
constexpr int BM = 256, BK = 64, HALF = 128, HTB = HALF * BK * 2, STAGE_BYTES = 8 * HTB, NXCD = 8, WGM = 4;
__device__ __forceinline__ int lds_byte(int r, int c) { const int st = (r >> 4) * 2 + (c >> 5), rr = r & 15, cc = c & 31, ob = rr * 64 + cc * 2; return st * 1024 + (ob ^ (((ob >> 9) & 1) << 5)); }
__device__ __forceinline__ void stage_rc(int b, int& R, int& C) { const int st = b / 1024, sb = b % 1024, swz = sb ^ (((sb >> 9) & 1) << 5); R = (st >> 1) * 16 + swz / 64; C = (st & 1) * 32 + (swz % 64) / 2; }
__device__ __forceinline__ int perm32(int rho) { const int n = rho >> 4, i = rho & 15; return 8 * (i >> 2) + 4 * n + (i & 3); }

struct Unit { int pm, pn; };
struct Gemm { const bf16_t* A; const bf16_t* Bt; int M, N, K, lda, ldb; };

struct StaticOrder {
    int nM, nN, nwg, G, c;
    __device__ void init(int M_, int N_, int G_, int c_) { nM = M_ / BM; nN = N_ / BM; nwg = nM * nN; asm volatile("" : "+s"(G_), "+s"(c_)); G = G_; c = c_; }
    __device__ bool next(int i, Unit& u) const {
        const long L = (long)i * G + c; if (L >= nwg) return false;
        int wgid = (int)L; { const int q = nwg / NXCD, r = nwg % NXCD, xcd = wgid % NXCD, off = wgid / NXCD; wgid = (xcd < r ? xcd * (q + 1) : r * (q + 1) + (xcd - r) * q) + off; }
        const int nig = WGM * nN, gid = wgid / nig, fm = gid * WGM, gsz = (nM - fm) < WGM ? (nM - fm) : WGM;
        u.pm = fm + ((wgid % nig) % gsz); u.pn = (wgid % nig) / gsz; return true;
    }
};


struct EpiProj {
    static constexpr bool FUSED = false, HOOK = false; bf16_t* P; float* DT;
    __device__ __forceinline__ void operator()(const f32x4 (&acc)[2][2][4][2], const Unit& u, int wr, int wc, int fr, int fq) const {
        asm volatile("" : "+v"(fr), "+v"(fq));
        const int row0 = u.pm * BM + wr * 64 + fr;
        if (u.pn == 23) {
            if (wc == 0 && fq == 0) {
#pragma unroll
                for (int ai = 0; ai < 2; ++ai)
#pragma unroll
                    for (int m = 0; m < 4; ++m) { float* d = DT + (size_t)(row0 + ai * HALF + m * 16) * 8;
                        *(f32x4*)d = acc[ai][0][m][0]; *(f32x4*)(d + 4) = acc[ai][0][m][1]; }
            }
            return;
        }
        bf16_t* base; int pitch, cb;
        if (u.pn < 4) { base = P + Y_OFF; pitch = YP; cb = u.pn * BM; } else if (u.pn < 11) { base = P + Q_OFF; pitch = QP; cb = (u.pn - 4) * BM; } else { base = P + G_OFF; pitch = GP; cb = (u.pn - 11) * BM; }
        const int col0 = cb + wc * 32 + 8 * fq;
#pragma unroll
        for (int ai = 0; ai < 2; ++ai)
#pragma unroll
            for (int m = 0; m < 4; ++m) { bf16_t* rowp = base + (size_t)(row0 + ai * HALF + m * 16) * pitch + col0;
#pragma unroll
                for (int bj = 0; bj < 2; ++bj) { f32x4 v0 = acc[ai][bj][m][0], v1 = acc[ai][bj][m][1];
                    if (u.pn >= 11) {
#pragma unroll
                        for (int e = 0; e < 4; ++e) { v0[e] = __expf(fminf(-v0[e], 60.f)); v1[e] = __expf(fminf(-v1[e], 60.f)); } }
                    u32x4 w; w.x = pk2(v0[0], v0[1]); w.y = pk2(v0[2], v0[3]); w.z = pk2(v1[0], v1[1]); w.w = pk2(v1[2], v1[3]);
                    *(u32x4*)(rowp + bj * HALF) = w; } }
    }
};

struct EpiGate3 {
    static constexpr bool FUSED = false, HOOK = true;
    bf16_t* O; const bf16_t* G;
    static __device__ __forceinline__ float en(float u) { return u; }
    __device__ __forceinline__ void hook(f32x4 (&acc)[2][2][4][2], const Unit& u, int t, int wr, int wc, int fr, int fq) const {
        asm volatile("" : "+v"(fr), "+v"(fq));
        const int row0 = u.pm * BM + wr * 64 + fr, col0 = u.pn * BM + wc * 32 + 8 * fq;
        const bf16_t* gp = G + (t == 4 ? 0 : 1024);
#pragma unroll
        for (int ai = 0; ai < 2; ++ai) {
            u32x4 ga[4][2], gb[4][2];
#pragma unroll
            for (int m = 0; m < 4; ++m)
#pragma unroll
                for (int bj = 0; bj < 2; ++bj) { const bf16_t* p = gp + (size_t)(row0 + ai * HALF + m * 16) * GP + col0 + bj * HALF; ga[m][bj] = *(const u32x4*)p; gb[m][bj] = *(const u32x4*)(p + 1024); }
            __builtin_amdgcn_sched_barrier(0);
#pragma unroll
            for (int m = 0; m < 4; ++m)
#pragma unroll
                for (int bj = 0; bj < 2; ++bj) { const u32x4 a = ga[m][bj], b = gb[m][bj];
                    f32x4 r0, r1;
                    r0[0] = (1.f + bflo(b.x)) * __builtin_amdgcn_rcpf(1.f + bflo(a.x)); r0[1] = (1.f + bfhi(b.x)) * __builtin_amdgcn_rcpf(1.f + bfhi(a.x));
                    r0[2] = (1.f + bflo(b.y)) * __builtin_amdgcn_rcpf(1.f + bflo(a.y)); r0[3] = (1.f + bfhi(b.y)) * __builtin_amdgcn_rcpf(1.f + bfhi(a.y));
                    r1[0] = (1.f + bflo(b.z)) * __builtin_amdgcn_rcpf(1.f + bflo(a.z)); r1[1] = (1.f + bfhi(b.z)) * __builtin_amdgcn_rcpf(1.f + bfhi(a.z));
                    r1[2] = (1.f + bflo(b.w)) * __builtin_amdgcn_rcpf(1.f + bflo(a.w)); r1[3] = (1.f + bfhi(b.w)) * __builtin_amdgcn_rcpf(1.f + bfhi(a.w));
                    acc[ai][bj][m][0] *= r0; acc[ai][bj][m][1] *= r1; }
            asm volatile("" ::: "memory"); __builtin_amdgcn_sched_barrier(0);
        }
    }
    __device__ __forceinline__ void operator()(const f32x4 (&acc)[2][2][4][2], const Unit& u, int wr, int wc, int fr, int fq) const {
        asm volatile("" : "+v"(fr), "+v"(fq));
        const int row0 = u.pm * BM + wr * 64 + fr, col0 = u.pn * BM + wc * 32 + 8 * fq;
#pragma unroll
        for (int ai = 0; ai < 2; ++ai)
#pragma unroll
            for (int m = 0; m < 4; ++m) { const size_t row = (size_t)(row0 + ai * HALF + m * 16);
#pragma unroll
                for (int bj = 0; bj < 2; ++bj) { const f32x4 v0 = acc[ai][bj][m][0], v1 = acc[ai][bj][m][1];
                    const u32x4 g = *(const u32x4*)(G + 2048 + row * GP + col0 + bj * HALF);
                    u32x4 w;
                    w.x = pk2(v0[0] * __builtin_amdgcn_rcpf(1.f + en(bflo(g.x))), v0[1] * __builtin_amdgcn_rcpf(1.f + en(bfhi(g.x)))); w.y = pk2(v0[2] * __builtin_amdgcn_rcpf(1.f + en(bflo(g.y))), v0[3] * __builtin_amdgcn_rcpf(1.f + en(bfhi(g.y))));
                    w.z = pk2(v1[0] * __builtin_amdgcn_rcpf(1.f + en(bflo(g.z))), v1[1] * __builtin_amdgcn_rcpf(1.f + en(bfhi(g.z)))); w.w = pk2(v1[2] * __builtin_amdgcn_rcpf(1.f + en(bflo(g.w))), v1[3] * __builtin_amdgcn_rcpf(1.f + en(bfhi(g.w))));
                    *(u32x4*)(O + row * D + col0 + bj * HALF) = w; }
                asm volatile("" ::: "memory"); }
    }
};
struct EpiSwiGLU {
    static constexpr bool FUSED = false, HOOK = false; bf16_t* O;
    __device__ __forceinline__ void operator()(const f32x4 (&acc)[2][2][4][2], const Unit& u, int wr, int wc, int fr, int fq) const {
        asm volatile("" : "+v"(fr), "+v"(fq));
        const int row0 = u.pm * BM + wr * 64 + fr, col0 = u.pn * HALF + wc * 32 + 8 * fq;
#pragma unroll
        for (int ai = 0; ai < 2; ++ai)
#pragma unroll
            for (int m = 0; m < 4; ++m) { bf16_t* rowp = O + (size_t)(row0 + ai * HALF + m * 16) * FFN + col0;
                const f32x4 g0 = acc[ai][0][m][0], g1 = acc[ai][0][m][1], u0 = acc[ai][1][m][0], u1 = acc[ai][1][m][1];
                u32x4 w; w.x = pk2(siluf_(g0[0]) * u0[0], siluf_(g0[1]) * u0[1]); w.y = pk2(siluf_(g0[2]) * u0[2], siluf_(g0[3]) * u0[3]);
                w.z = pk2(siluf_(g1[0]) * u1[0], siluf_(g1[1]) * u1[1]); w.w = pk2(siluf_(g1[2]) * u1[2], siluf_(g1[3]) * u1[3]);
                *(u32x4*)rowp = w; }
    }
};


struct PanelSq {
    float* xbuf;
    unsigned* cnt;
    unsigned need;
    __device__ __forceinline__ void run(const f32x4 (&v)[2][2][4][2], const Unit& u, int wr, int wc, int fr, int fq, LAS unsigned char* ldsx, int wid, int lane) const {
        LAS float* Pp = (LAS float*)ldsx; LAS float* S = (LAS float*)(ldsx + 4096);
#pragma unroll
        for (int ai = 0; ai < 2; ++ai)
#pragma unroll
            for (int m = 0; m < 4; ++m) {
                float q = 0.f;
#pragma unroll
                for (int bj = 0; bj < 2; ++bj)
#pragma unroll
                    for (int n = 0; n < 2; ++n) { const f32x4 x = v[ai][bj][m][n]; q += (x[0] * x[0] + x[1] * x[1]) + (x[2] * x[2] + x[3] * x[3]); }
                q += __shfl_xor(q, 16); q += __shfl_xor(q, 32);
                if (fq == 0) Pp[(ai * HALF + wr * 64 + m * 16 + fr) * 4 + wc] = q;
            }
        asm volatile("s_waitcnt lgkmcnt(0)" ::: "memory"); __builtin_amdgcn_s_barrier(); asm volatile("" ::: "memory");
        const int row = wid * 32 + (lane & 31);
        if (lane < 32) {
            const float q = (Pp[row * 4 + 0] + Pp[row * 4 + 1]) + (Pp[row * 4 + 2] + Pp[row * 4 + 3]);
            __hip_atomic_store(xbuf + ((size_t)(u.pm * BM + row) * 4 + u.pn), q, __ATOMIC_RELAXED, __HIP_MEMORY_SCOPE_AGENT);
        }
        asm volatile("s_waitcnt vmcnt(0)" ::: "memory");
        if (lane == 0) __hip_atomic_fetch_add(cnt + 64 * u.pm, 1u, __ATOMIC_RELAXED, __HIP_MEMORY_SCOPE_AGENT);
        if (wid == 0) {
            unsigned sp = 0;
            while ((unsigned)__builtin_amdgcn_readfirstlane(__hip_atomic_load(cnt + 64 * u.pm, __ATOMIC_RELAXED, __HIP_MEMORY_SCOPE_AGENT)) < need) { __builtin_amdgcn_s_sleep(2); if (++sp > (1u << 22)) break; }
            __builtin_amdgcn_fence(__ATOMIC_ACQUIRE, "agent");
        }
        asm volatile("s_waitcnt vmcnt(0) lgkmcnt(0)" ::: "memory"); __builtin_amdgcn_s_barrier(); asm volatile("" ::: "memory");
        if (lane < 32) {
            const float* slot = xbuf + (size_t)(u.pm * BM + row) * 4; float t = 0.f;
#pragma unroll
            for (int k = 0; k < 4; ++k) t += __hip_atomic_load(slot + k, __ATOMIC_RELAXED, __HIP_MEMORY_SCOPE_AGENT);
            S[row] = t;
        }
        asm volatile("s_waitcnt lgkmcnt(0)" ::: "memory"); __builtin_amdgcn_s_barrier(); asm volatile("" ::: "memory");
    }
};
template <bool XIN_BF16, bool XOUT_BF16> struct EpiResNorm {
    static constexpr bool FUSED = true, HOOK = false;
    __device__ __forceinline__ void load8(size_t off, f32x4& v0, f32x4& v1) const {
        if (XIN_BF16) { const u32x4 w = *(const u32x4*)((const bf16_t*)xin + off); v0 = (f32x4){bflo(w.x), bfhi(w.x), bflo(w.y), bfhi(w.y)}; v1 = (f32x4){bflo(w.z), bfhi(w.z), bflo(w.w), bfhi(w.w)}; }
        else { v0 = *(const f32x4*)((const float*)xin + off); v1 = *(const f32x4*)((const float*)xin + off + 4); } }
    __device__ __forceinline__ void store8(size_t off, const f32x4& v0, const f32x4& v1) const {
        if (XOUT_BF16) { u32x4 w; w.x = pk2(v0[0], v0[1]); w.y = pk2(v0[2], v0[3]); w.z = pk2(v1[0], v1[1]); w.w = pk2(v1[2], v1[3]); *(u32x4*)((bf16_t*)xout + off) = w; }
        else { *(f32x4*)((float*)xout + off) = v0; *(f32x4*)((float*)xout + off + 4) = v1; } }
    const void* xin; void* xout; const float* gate; const float* gpost; int do_next; const float* gn; const float* scn; const float* shn; bf16_t* hout; PanelSq st1, st2;
    __device__ __forceinline__ void fused(f32x4 (&acc)[2][2][4][2], const Unit& u, int wr, int wc, int fr, int fq, LAS unsigned char* ldsx, int wid, int lane) const {
        asm volatile("" : "+v"(fr), "+v"(fq));
        const LAS float* S = (const LAS float*)(ldsx + 4096);
        const int col0 = u.pn * BM + wc * 32 + 8 * fq;
        const int boff = (u.pm * BM >= SEQ) ? 6144 : 0;
        const float* gate = this->gate + boff; const float* scn = this->scn + boff; const float* shn = this->shn + boff;
        f32x4 g1[2][2];
#pragma unroll
        for (int bj = 0; bj < 2; ++bj)
#pragma unroll
            for (int n = 0; n < 2; ++n) { const int c = bj * HALF + 4 * n; g1[bj][n] = *(const f32x4*)(gate + col0 + c) * *(const f32x4*)(gpost + col0 + c); }
        f32x4 pre[2][2][2];
#pragma unroll
        for (int m = 0; m < 2; ++m) { const size_t off = (size_t)(u.pm * BM + wr * 64 + m * 16 + fr) * 1024 + col0;
#pragma unroll
            for (int bj = 0; bj < 2; ++bj) load8(off + bj * HALF, pre[m][bj][0], pre[m][bj][1]); }
        st1.run(acc, u, wr, wc, fr, fq, ldsx, wid, lane);
#pragma unroll
        for (int ai = 0; ai < 2; ++ai)
#pragma unroll
            for (int m = 0; m < 4; ++m) { const int r = ai * HALF + wr * 64 + m * 16 + fr; const float rs = __builtin_amdgcn_rsqf(S[r] * (1.f / 1024.f) + EPS); const size_t off = (size_t)(u.pm * BM + r) * 1024 + col0;
#pragma unroll
                for (int bj = 0; bj < 2; ++bj) { f32x4 xv0, xv1;
                    if (ai == 0 && m < 2) { xv0 = pre[m & 1][bj][0]; xv1 = pre[m & 1][bj][1]; } else load8(off + bj * HALF, xv0, xv1);
                    const f32x4 x10 = xv0 + g1[bj][0] * (acc[ai][bj][m][0] * rs), x11 = xv1 + g1[bj][1] * (acc[ai][bj][m][1] * rs);
                    store8(off + bj * HALF, x10, x11); acc[ai][bj][m][0] = x10; acc[ai][bj][m][1] = x11; }
                asm volatile("" : "+v"(acc[ai][0][m][0]), "+v"(acc[ai][0][m][1]), "+v"(acc[ai][1][m][0]), "+v"(acc[ai][1][m][1]));
                if (m & 1) asm volatile("" ::: "memory"); }
        if (do_next) {
            f32x4 a2[2][2], b2[2][2];
#pragma unroll
            for (int bj = 0; bj < 2; ++bj)
#pragma unroll
                for (int n = 0; n < 2; ++n) { const int c = bj * HALF + 4 * n; a2[bj][n] = *(const f32x4*)(gn + col0 + c) * (*(const f32x4*)(scn + col0 + c) + 1.f); b2[bj][n] = *(const f32x4*)(shn + col0 + c); }
            st2.run(acc, u, wr, wc, fr, fq, ldsx, wid, lane);
#pragma unroll
            for (int ai = 0; ai < 2; ++ai)
#pragma unroll
                for (int m = 0; m < 4; ++m) { const int r = ai * HALF + wr * 64 + m * 16 + fr; const float rs = __builtin_amdgcn_rsqf(S[r] * (1.f / 1024.f) + EPS); const size_t off = (size_t)(u.pm * BM + r) * 1024 + col0;
#pragma unroll
                    for (int bj = 0; bj < 2; ++bj) { const f32x4 h0 = acc[ai][bj][m][0] * rs * a2[bj][0] + b2[bj][0], h1 = acc[ai][bj][m][1] * rs * a2[bj][1] + b2[bj][1];
                        u32x4 w; w.x = pk2(h0[0], h0[1]); w.y = pk2(h0[2], h0[3]); w.z = pk2(h1[0], h1[1]); w.w = pk2(h1[2], h1[3]);
                        *(u32x4*)(hout + off + bj * HALF) = w; } }
        }
    }
};

template <class Epi>
__device__ __forceinline__ void gemm_phase(LAS unsigned char* lds, const Gemm g, const StaticOrder& S, const Epi& E) {
    int tid = threadIdx.x; asm volatile("" : "+v"(tid));
    const int wid = __builtin_amdgcn_readfirstlane(tid >> 6), lane = tid & 63, wr = wid >> 2, wc = wid & 3, fr = lane & 15, fq = lane >> 4;
    const int K = g.K, nt = K / BK;
    unsigned voffA[2], voffB[2];
#pragma unroll
    for (int i = 0; i < 2; ++i) { int R, C; stage_rc(tid * 16 + i * 8192, R, C); const int Rb = (R & ~31) + perm32(R & 31);
        voffA[i] = (unsigned)(R * g.lda + C) * 2u; voffB[i] = (unsigned)(Rb * g.ldb + C) * 2u; }
    const size_t kstep = (size_t)(BK * 2);
    const size_t hstepA = (size_t)HALF * g.lda * 2, hstepB = (size_t)HALF * g.ldb * 2;
    const size_t tstepA = 2 * hstepA, tstepB = 2 * hstepB;
    const unsigned ldsw = (unsigned)wid * 1024u;
    const int aoff = lds_byte(wr * 64 + fr, fq * 8), boff = lds_byte(wc * 32 + fr, fq * 8);
#define PG8_SA(b, h) (((b) * 2 + (h)) * HTB)
#define PG8_SB(b, h) ((4 + (b) * 2 + (h)) * HTB)
#define PG8_STAGE(bufoff, gbase, voff) do { _Pragma("unroll") for (int _i = 0; _i < 2; ++_i) \
        __builtin_amdgcn_global_load_lds((const unsigned*)((const char*)(gbase) + (voff)[_i]), (LAS unsigned*)(lds + (bufoff) + ldsw + _i * 8192), 16, 0, 0); } while (0)
#define PG8_LDA(dst, b, h) do { _Pragma("unroll") for (int m = 0; m < 4; ++m) _Pragma("unroll") for (int k = 0; k < 2; ++k) dst[m][k] = *(const LAS bf16x8*)(lds + PG8_SA(b, h) + aoff + m * 2048 + k * 1024); } while (0)
#define PG8_LDB(dst, b, h) do { _Pragma("unroll") for (int n = 0; n < 2; ++n) _Pragma("unroll") for (int k = 0; k < 2; ++k) dst[n][k] = *(const LAS bf16x8*)(lds + PG8_SB(b, h) + boff + n * 2048 + k * 1024); } while (0)
#define PG8_MMA(ai, bj, At, Bt) do { __builtin_amdgcn_s_setprio(1); _Pragma("unroll") for (int m = 0; m < 4; ++m) _Pragma("unroll") for (int n = 0; n < 2; ++n) _Pragma("unroll") for (int k = 0; k < 2; ++k) \
        acc[ai][bj][m][n] = __builtin_amdgcn_mfma_f32_16x16x32_bf16(Bt[n][k], At[m][k], acc[ai][bj][m][n], 0, 0, 0); __builtin_amdgcn_s_setprio(0); } while (0)
#define PG8_WAIT_V(n) asm volatile("s_waitcnt vmcnt(" #n ")" ::: "memory")
#define PG8_WAIT_L(n) asm volatile("s_waitcnt lgkmcnt(" #n ")" ::: "memory")
#define PG8_BAR __builtin_amdgcn_s_barrier()
#define PG8_SCHED __builtin_amdgcn_sched_barrier(0)
    Unit cur, nxt; int ui = 0;
    if (!S.next(0, cur)) return;
    f32x4 acc[2][2][4][2];
#pragma unroll
    for (int a = 0; a < 2; ++a)
#pragma unroll
        for (int b = 0; b < 2; ++b)
#pragma unroll
            for (int m = 0; m < 4; ++m)
#pragma unroll
                for (int n = 0; n < 2; ++n) acc[a][b][m][n] = (f32x4){0.f, 0.f, 0.f, 0.f};
    bf16x8 At[4][2], B0[2][2], B1[2][2];
    const char* cA = (const char*)g.A + (size_t)cur.pm * tstepA; const char* cB = (const char*)g.Bt + (size_t)cur.pn * tstepB;
    PG8_STAGE(PG8_SB(0, 0), cB, voffB); PG8_STAGE(PG8_SB(0, 1), cB + hstepB, voffB); PG8_STAGE(PG8_SA(0, 0), cA, voffA); PG8_STAGE(PG8_SA(0, 1), cA + hstepA, voffA);
    if (wr == 1) PG8_BAR;
    PG8_WAIT_V(2); PG8_BAR;
    PG8_STAGE(PG8_SB(1, 0), cB + kstep, voffB); PG8_STAGE(PG8_SA(1, 0), cA + kstep, voffA); PG8_STAGE(PG8_SB(1, 1), cB + hstepB + kstep, voffB);
    PG8_WAIT_V(6); PG8_BAR;
    for (;;) {
        const bool has_next = S.next(ui + 1, nxt);
        const char* nA = has_next ? (const char*)g.A + (size_t)nxt.pm * tstepA : cA; const char* nB = has_next ? (const char*)g.Bt + (size_t)nxt.pn * tstepB : cB;
#pragma unroll 1
        for (int t = 0; t < nt; t += 2) {
            if constexpr (Epi::HOOK) { if (t == 4 || t == 8) E.hook(acc, cur, t, wr, wc, fr, fq); }
            const bool last = (t == nt - 2);
            const char* a1 = cA + (size_t)(t + 1) * kstep;
            const char* a2 = last ? nA : cA + (size_t)(t + 2) * kstep; const char* b2 = last ? nB : cB + (size_t)(t + 2) * kstep;
            const char* a3 = a2 + kstep; const char* b3 = b2 + kstep;
            PG8_LDB(B0, 0, 0); PG8_LDB(B1, 0, 1); PG8_SCHED; PG8_LDA(At, 0, 0); PG8_STAGE(PG8_SA(1, 1), a1 + hstepA, voffA);
            PG8_WAIT_V(8); PG8_WAIT_L(0); PG8_BAR; PG8_MMA(0, 0, At, B0); PG8_MMA(0, 1, At, B1); PG8_BAR; PG8_SCHED;
            PG8_LDA(At, 0, 1); PG8_STAGE(PG8_SB(0, 0), b2, voffB); PG8_STAGE(PG8_SB(0, 1), b2 + hstepB, voffB); PG8_STAGE(PG8_SA(0, 0), a2, voffA);
            PG8_WAIT_V(8); PG8_WAIT_L(0); PG8_BAR; PG8_MMA(1, 0, At, B0); PG8_MMA(1, 1, At, B1); PG8_BAR; PG8_SCHED;
            PG8_LDB(B0, 1, 0); PG8_LDB(B1, 1, 1); PG8_SCHED; PG8_LDA(At, 1, 0); PG8_STAGE(PG8_SA(0, 1), a2 + hstepA, voffA);
            PG8_WAIT_V(8); PG8_WAIT_L(0); PG8_BAR; PG8_MMA(0, 0, At, B0); PG8_MMA(0, 1, At, B1); PG8_BAR; PG8_SCHED;
            PG8_LDA(At, 1, 1); PG8_STAGE(PG8_SB(1, 0), b3, voffB); PG8_STAGE(PG8_SB(1, 1), b3 + hstepB, voffB); PG8_STAGE(PG8_SA(1, 0), a3, voffA);
            PG8_WAIT_V(8); PG8_WAIT_L(0); PG8_BAR; PG8_MMA(1, 0, At, B0); PG8_MMA(1, 1, At, B1); PG8_BAR; PG8_SCHED;
        }
        if (wr == 0) PG8_BAR;
        if constexpr (Epi::FUSED) E.fused(acc, cur, wr, wc, fr, fq, lds + STAGE_BYTES, wid, lane); else E(acc, cur, wr, wc, fr, fq);
        if (!has_next) break;
#pragma unroll
        for (int a = 0; a < 2; ++a)
#pragma unroll
            for (int b = 0; b < 2; ++b)
#pragma unroll
                for (int m = 0; m < 4; ++m)
#pragma unroll
                    for (int n = 0; n < 2; ++n) acc[a][b][m][n] = (f32x4){0.f, 0.f, 0.f, 0.f};
        cur = nxt; cA = nA; cB = nB; ++ui;
        if (wr == 1) PG8_BAR;
    }
    PG8_WAIT_V(0);
    PG8_BAR;
#undef PG8_SA
#undef PG8_SB
#undef PG8_STAGE
#undef PG8_LDA
#undef PG8_LDB
#undef PG8_MMA
#undef PG8_WAIT_V
#undef PG8_WAIT_L
#undef PG8_BAR
#undef PG8_SCHED
}
}

constexpr int NWAVES = 8, NTHREADS = 512;
constexpr int LDS_BYTES = 147456;

__device__ __forceinline__ void tr_item(const float* W, int ldw, int src_col0, int nvalid, int k0, bf16_t* WT, int ldwt, int dst_row0, int dst_col0, LAS float* scr, int lane) {
    const int kr = lane >> 3, jq = lane & 7;
    f32x4 v[8];
#pragma unroll
    for (int i = 0; i < 8; ++i) { v[i] = (f32x4){0.f, 0.f, 0.f, 0.f}; if (4 * jq < nvalid) v[i] = *(const f32x4*)(W + (size_t)(k0 + 8 * i + kr) * ldw + src_col0 + 4 * jq); }
#pragma unroll
    for (int i = 0; i < 8; ++i) { LAS float* d = scr + (8 * i + kr) * 33 + 4 * jq; d[0] = v[i][0]; d[1] = v[i][1]; d[2] = v[i][2]; d[3] = v[i][3]; }
    LDS_WAIT();
    const int c = lane & 7;
#pragma unroll
    for (int q = 0; q < 4; ++q) { const int n = (lane >> 3) + 8 * q; const LAS float* s = scr + (8 * c) * 33 + n;
        u32x4 o; o.x = pk2(s[0 * 33], s[1 * 33]); o.y = pk2(s[2 * 33], s[3 * 33]); o.z = pk2(s[4 * 33], s[5 * 33]); o.w = pk2(s[6 * 33], s[7 * 33]);
        *(u32x4*)(WT + (size_t)(dst_row0 + n) * ldwt + dst_col0 + k0 + 8 * c) = o; }
    LDS_WAIT();
}
__device__ __forceinline__ void win_map(int d0, int& src, int& nvalid) {
    nvalid = 32;
    if (d0 < 256) src = d0;
    else if (d0 < 512) src = 768 + (d0 - 256);
    else if (d0 < 1024) src = 1536 + (d0 - 512);
    else if (d0 < 1280) src = 256 + (d0 - 1024);
    else if (d0 < 1536) src = 512 + (d0 - 1280);
    else if (d0 < 1792) src = 1024 + (d0 - 1536);
    else if (d0 < 2048) src = 1280 + (d0 - 1792);
    else if (d0 < 2816) src = d0;
    else if (d0 < 5888) src = d0 + 8;
    else if (d0 == 5888) { src = 2816; nvalid = 8; }
    else { src = 0; nvalid = 0; }
}
constexpr int TR_PER_LAYER = 3072 + 128 + 128 + 256 + 512 + 2816 + 1408;
__device__ __forceinline__ void tr_dispatch(KA a, int it, LAS float* scr, int lane) {
    const int l = it / TR_PER_LAYER; int r = it % TR_PER_LAYER;
    unsigned char* wl = a->ws + WS_W + (size_t)l * W_LAYER;
    if (r < 3072) { const int kb = r / 192, nb = r % 192, d0 = nb * 32; int src, nv; win_map(d0, src, nv);
        tr_item(a->in[IN_WIN] + (size_t)l * D * NSRC, NSRC, src, nv, kb * 64, (bf16_t*)(wl + W_IN), D, d0, 0, scr, lane); return; }
    r -= 3072;
    if (r < 128) { const int kb = r / 32, nb = r % 32; tr_item(a->in[IN_WSC] + (size_t)l * 256 * D, D, nb * 32, 32, kb * 64, (bf16_t*)(wl + W_OUT3), D, nb * 32, 0, scr, lane); return; }
    r -= 128;
    if (r < 128) { const int kb = r / 32, nb = r % 32; tr_item(a->in[IN_WSB] + (size_t)l * 256 * D, D, nb * 32, 32, kb * 64, (bf16_t*)(wl + W_OUT3), D, nb * 32, 256, scr, lane); return; }
    r -= 128;
    if (r < 256) { const int kb = r / 32, nb = r % 32; tr_item(a->in[IN_WSSM] + (size_t)l * 512 * D, D, nb * 32, 32, kb * 64, (bf16_t*)(wl + W_OUT3), D, nb * 32, 512, scr, lane); return; }
    r -= 256;
    if (r < 512) { const int kb = r / 32, nb = r % 32; tr_item(a->in[IN_WO] + (size_t)l * D * D, D, nb * 32, 32, kb * 64, (bf16_t*)(wl + W_O), D, nb * 32, 0, scr, lane); return; }
    r -= 512;
    if (r < 2816) { const int kb = r / 176, nb = r % 176, d0 = nb * 32, pn = d0 >> 8, within = d0 & 255, half = within >> 7, i = within & 127;
        tr_item(a->in[IN_WFI] + (size_t)l * D * 2 * FFN, 2 * FFN, half * FFN + pn * 128 + i, 32, kb * 64, (bf16_t*)(wl + W_FI), D, d0, 0, scr, lane); return; }
    r -= 2816;
    { const int kb = r / 32, nb = r % 32; tr_item(a->in[IN_WFO] + (size_t)l * FFN * D, D, nb * 32, 32, kb * 64, (bf16_t*)(wl + W_FO), FFN, nb * 32, 0, scr, lane); }
}
__device__ __forceinline__ void mod_item(KA a, int item, LAS float* red, int tid) {
    const int l = item / 96, nb = item % 96, n0 = nb * 64, j4 = tid & 15, ks = tid >> 4;
    const float* w = a->in[IN_MODW] + (size_t)l * D * 6144 + n0 + 4 * j4; const float* c = a->in[IN_C];
    f32x4 a0 = {0.f, 0.f, 0.f, 0.f}, a1 = {0.f, 0.f, 0.f, 0.f};
#pragma unroll 16
    for (int k = ks * 32; k < ks * 32 + 32; ++k) { const f32x4 wv = *(const f32x4*)(w + (size_t)k * 6144); a0 += wv * siluf_(c[k]); a1 += wv * siluf_(c[D + k]); }
    *(LAS f32x4*)(red + (ks * 2 + 0) * 64 + 4 * j4) = a0; *(LAS f32x4*)(red + (ks * 2 + 1) * 64 + 4 * j4) = a1;
    __syncthreads();
    if (tid < 128) { const int b = tid >> 6, j = tid & 63; float s = 0.f;
#pragma unroll
        for (int q = 0; q < 32; ++q) s += red[(q * 2 + b) * 64 + j];
        ((float*)(a->ws + WS_MOD))[(size_t)(l * 2 + b) * 6144 + n0 + j] = s + a->in[IN_MODB][(size_t)l * 6144 + n0 + j]; }
    __syncthreads();
}

__device__ __forceinline__ void prenorm_row(const float* xrow, const float* g, const float* scale, const float* shift, bf16_t* hrow, int lane) {
    f32x4 v[4]; float ss = 0.f;
#pragma unroll
    for (int j = 0; j < 4; ++j) { v[j] = *(const f32x4*)(xrow + 4 * lane + 256 * j); ss += (v[j][0] * v[j][0] + v[j][1] * v[j][1]) + (v[j][2] * v[j][2] + v[j][3] * v[j][3]); }
    const float rs = 1.0f / sqrtf(wave_sum(ss) * (1.f / D) + EPS);
#pragma unroll
    for (int j = 0; j < 4; ++j) { const int col = 4 * lane + 256 * j;
        const f32x4 gg = *(const f32x4*)(g + col), sc = *(const f32x4*)(scale + col), sh = *(const f32x4*)(shift + col);
        const f32x4 h = v[j] * rs * gg * (sc + 1.f) + sh;
        u32x2 w; w.x = pk2(h[0], h[1]); w.y = pk2(h[2], h[3]); *(u32x2*)(hrow + col) = w; }
}
__device__ __forceinline__ void shortconv_phase(KA a, int l, bf16_t* P, int tid, int vb, int nb) {
    const float* scw = a->in[IN_SCW] + (size_t)l * 3 * 256;
    for (int it = vb * NTHREADS + tid; it < (M / 8) * 32; it += nb * NTHREADS) {
        const int cg8 = it & 31, rb = it >> 5, row0 = rb * 8, tseq = row0 & (SEQ - 1), ch0 = cg8 * 8;
        float w0[8], w1[8], w2[8], c1[8], c2[8];
#pragma unroll
        for (int i = 0; i < 8; ++i) { w0[i] = scw[ch0 + i]; w1[i] = scw[256 + ch0 + i]; w2[i] = scw[512 + ch0 + i]; c1[i] = 0.f; c2[i] = 0.f; }
        if (tseq != 0) {
            const bf16_t* r2 = P + Q_OFF + (size_t)(row0 - 2) * QP + ch0; const bf16_t* r1 = P + Q_OFF + (size_t)(row0 - 1) * QP + ch0;
            const u32x4 cc2 = *(const u32x4*)(r2 + QC_SCC), xx2 = *(const u32x4*)(r2 + QC_SCX), cc1 = *(const u32x4*)(r1 + QC_SCC), xx1 = *(const u32x4*)(r1 + QC_SCX);
            c2[0] = bflo(cc2.x) * bflo(xx2.x); c2[1] = bfhi(cc2.x) * bfhi(xx2.x); c2[2] = bflo(cc2.y) * bflo(xx2.y); c2[3] = bfhi(cc2.y) * bfhi(xx2.y);
            c2[4] = bflo(cc2.z) * bflo(xx2.z); c2[5] = bfhi(cc2.z) * bfhi(xx2.z); c2[6] = bflo(cc2.w) * bflo(xx2.w); c2[7] = bfhi(cc2.w) * bfhi(xx2.w);
            c1[0] = bflo(cc1.x) * bflo(xx1.x); c1[1] = bfhi(cc1.x) * bfhi(xx1.x); c1[2] = bflo(cc1.y) * bflo(xx1.y); c1[3] = bfhi(cc1.y) * bfhi(xx1.y);
            c1[4] = bflo(cc1.z) * bflo(xx1.z); c1[5] = bfhi(cc1.z) * bfhi(xx1.z); c1[6] = bflo(cc1.w) * bflo(xx1.w); c1[7] = bfhi(cc1.w) * bfhi(xx1.w);
        }
#pragma unroll
        for (int r = 0; r < 8; ++r) {
            bf16_t* yp = P + Y_OFF + (size_t)(row0 + r) * YP + ch0 + YC_A; const bf16_t* qp = P + Q_OFF + (size_t)(row0 + r) * QP + ch0;
            const u32x4 bb = *(const u32x4*)yp, cc = *(const u32x4*)(qp + QC_SCC), xx = *(const u32x4*)(qp + QC_SCX);
            float c0[8], bv[8], y[8];
            c0[0] = bflo(cc.x) * bflo(xx.x); c0[1] = bfhi(cc.x) * bfhi(xx.x); c0[2] = bflo(cc.y) * bflo(xx.y); c0[3] = bfhi(cc.y) * bfhi(xx.y);
            c0[4] = bflo(cc.z) * bflo(xx.z); c0[5] = bfhi(cc.z) * bfhi(xx.z); c0[6] = bflo(cc.w) * bflo(xx.w); c0[7] = bfhi(cc.w) * bfhi(xx.w);
            bv[0] = bflo(bb.x); bv[1] = bfhi(bb.x); bv[2] = bflo(bb.y); bv[3] = bfhi(bb.y); bv[4] = bflo(bb.z); bv[5] = bfhi(bb.z); bv[6] = bflo(bb.w); bv[7] = bfhi(bb.w);
#pragma unroll
            for (int i = 0; i < 8; ++i) { y[i] = bv[i] * (w0[i] * c2[i] + w1[i] * c1[i] + w2[i] * c0[i]); c2[i] = c1[i]; c1[i] = c0[i]; }
            u32x4 w; w.x = pk2(y[0], y[1]); w.y = pk2(y[2], y[3]); w.z = pk2(y[4], y[5]); w.w = pk2(y[6], y[7]);
            *(u32x4*)yp = w;
        }
    }
}


typedef float f32x16 __attribute__((ext_vector_type(16)));

template <bool MASKED>
__device__ __forceinline__ void attn_weights(const f32x16 (&st)[2], int s0, int tq, int h, float& run, unsigned (&wp)[2][8]) {
#pragma unroll
    for (int kt = 1; kt >= 0; --kt) {
        float lkv[16], zz[16], T[4], Tp[4];
#pragma unroll
        for (int i = 0; i < 16; ++i) { const float y = st[kt][i] * 1.4426950408889634f;
            const float sp = fmaxf(y, 0.f) + __builtin_amdgcn_logf(1.f + __builtin_amdgcn_exp2f(-fabsf(y)));
            if (MASKED) { const bool valid = (s0 + 32 * kt + (i & 3) + 8 * (i >> 2) + 4 * h) < tq; lkv[i] = valid ? -sp : 0.f; zz[i] = valid ? y - sp : -INFINITY; }
            else { lkv[i] = -sp; zz[i] = y - sp; } }
#pragma unroll
        for (int gq = 0; gq < 4; ++gq) { T[gq] = (lkv[4 * gq] + lkv[4 * gq + 1]) + (lkv[4 * gq + 2] + lkv[4 * gq + 3]); Tp[gq] = __shfl_xor(T[gq], 32); }
        float later = run;
#pragma unroll
        for (int gq = 3; gq >= 0; --gq) {
            const float r3 = later + (h == 0 ? Tp[gq] : 0.f), r2 = r3 + lkv[4 * gq + 3], r1 = r2 + lkv[4 * gq + 2], r0 = r1 + lkv[4 * gq + 1];
            const float w0 = __builtin_amdgcn_exp2f(zz[4 * gq + 0] + r0), w1 = __builtin_amdgcn_exp2f(zz[4 * gq + 1] + r1), w2 = __builtin_amdgcn_exp2f(zz[4 * gq + 2] + r2), w3 = __builtin_amdgcn_exp2f(zz[4 * gq + 3] + r3);
            wp[kt][2 * gq] = pk2(w0, w1); wp[kt][2 * gq + 1] = pk2(w2, w3);
            later += T[gq] + Tp[gq];
        }
        run = later;
    }
}
__device__ __forceinline__ void attn_mfma_unit(bf16_t* P, int unit, LAS unsigned char* wl, int lane) {
    const int qt = unit & 511, hh = (unit >> 9) & 3, b = unit >> 11;
    bf16_t* Yb = P + Y_OFF + (size_t)b * SEQ * YP; const bf16_t* Qb = P + Q_OFF + (size_t)b * SEQ * QP;
    const int q0 = qt * 32, c = lane & 31, h = lane >> 5, tq = q0 + c;
    bf16x8 qf[4];
    { const bf16_t* qp = Yb + (size_t)tq * YP + YC_B + hh * 64 + 8 * h;
#pragma unroll
      for (int ks = 0; ks < 4; ++ks) { const u32x4 w = *(const u32x4*)(qp + 16 * ks); u32x4 o;
          o.x = pk2(bflo(w.x) * 0.125f, bfhi(w.x) * 0.125f); o.y = pk2(bflo(w.y) * 0.125f, bfhi(w.y) * 0.125f);
          o.z = pk2(bflo(w.z) * 0.125f, bfhi(w.z) * 0.125f); o.w = pk2(bflo(w.w) * 0.125f, bfhi(w.w) * 0.125f);
          qf[ks] = __builtin_bit_cast(bf16x8, o); } }
    f32x16 zacc[2];
#pragma unroll
    for (int i = 0; i < 16; ++i) { zacc[0][i] = 0.f; zacc[1][i] = 0.f; }
    float R = 0.f;
    for (int kb = q0 >> 6; kb >= 0; --kb) {
        const int s0 = kb * 64;
        u32x4 vv[8];
        { const u32x4* vrow = (const u32x4*)(Qb + (size_t)(s0 + lane) * QP + QC_V + hh * 64);
#pragma unroll
          for (int i = 0; i < 8; ++i) vv[i] = vrow[i]; }
        bf16x8 kf[2][4];
        { const bf16_t* kp = Qb + (size_t)(s0 + c) * QP + QC_K + hh * 64 + 8 * h;
#pragma unroll
          for (int kt = 0; kt < 2; ++kt)
#pragma unroll
              for (int ks = 0; ks < 4; ++ks) kf[kt][ks] = *(const bf16x8*)(kp + (size_t)32 * kt * QP + 16 * ks); }
        f32x16 st[2];
#pragma unroll
        for (int kt = 0; kt < 2; ++kt) {
#pragma unroll
            for (int i = 0; i < 16; ++i) st[kt][i] = 0.f;
#pragma unroll
            for (int ks = 0; ks < 4; ++ks) st[kt] = __builtin_amdgcn_mfma_f32_32x32x16_bf16(kf[kt][ks], qf[ks], st[kt], 0, 0, 0);
        }
#pragma unroll
        for (int i = 0; i < 8; ++i) { const u32x4 w = vv[i]; LAS unsigned char* base = wl + (8 * i) * 136 + lane * 2;
            *(LAS unsigned short*)(base + 0 * 136) = (unsigned short)(w.x & 0xffffu); *(LAS unsigned short*)(base + 1 * 136) = (unsigned short)(w.x >> 16);
            *(LAS unsigned short*)(base + 2 * 136) = (unsigned short)(w.y & 0xffffu); *(LAS unsigned short*)(base + 3 * 136) = (unsigned short)(w.y >> 16);
            *(LAS unsigned short*)(base + 4 * 136) = (unsigned short)(w.z & 0xffffu); *(LAS unsigned short*)(base + 5 * 136) = (unsigned short)(w.z >> 16);
            *(LAS unsigned short*)(base + 6 * 136) = (unsigned short)(w.w & 0xffffu); *(LAS unsigned short*)(base + 7 * 136) = (unsigned short)(w.w >> 16); }
        unsigned wp[2][8];
        float run = R;
        if (kb == (q0 >> 6)) attn_weights<true>(st, s0, tq, h, run, wp); else attn_weights<false>(st, s0, tq, h, run, wp);
        R = run;
        LDS_WAIT();
#pragma unroll
        for (int kt = 0; kt < 2; ++kt)
#pragma unroll
            for (int s2 = 0; s2 < 2; ++s2) {
                u32x4 af; af.x = wp[kt][4 * s2 + 0]; af.y = wp[kt][4 * s2 + 1]; af.z = wp[kt][4 * s2 + 2]; af.w = wp[kt][4 * s2 + 3];
                const bf16x8 afrag = __builtin_bit_cast(bf16x8, af);
#pragma unroll
                for (int dt = 0; dt < 2; ++dt) {
                    const LAS unsigned char* vp = wl + (c + 32 * dt) * 136 + (32 * kt + 16 * s2 + 4 * h) * 2;
                    const u32x2 lo = *(const LAS u32x2*)vp, hi = *(const LAS u32x2*)(vp + 16);
                    u32x4 bfv; bfv.x = lo.x; bfv.y = lo.y; bfv.z = hi.x; bfv.w = hi.y;
                    zacc[dt] = __builtin_amdgcn_mfma_f32_32x32x16_bf16(afrag, __builtin_bit_cast(bf16x8, bfv), zacc[dt], 0, 0, 0);
                }
            }
        LDS_WAIT();
        if (__all(R < -150.1f)) break;
    }
#pragma unroll
    for (int dt = 0; dt < 2; ++dt)
#pragma unroll
        for (int i = 0; i < 16; ++i) Yb[(size_t)(q0 + (i & 3) + 8 * (i >> 2) + 4 * h) * YP + YC_B + hh * 64 + c + 32 * dt] = (bf16_t)f2bf(zacc[dt][i]);
}


constexpr int L_XT = 0, L_BN = 69632, L_CN = 87040, L_BT = 104448, L_ACS = 121856, L_DTV = 123904, L_ATAB = 125952, L_SS = 128000, L_NW = 130048;
template <bool OUT>
__device__ __forceinline__ void ssd2_stage(KA a, int l, const bf16_t* Qb, int b, int t0, LAS unsigned char* lds, int tid) {
    const float* cw = a->in[IN_SSMCW] + (size_t)l * 4 * 768; const float* cbias = a->in[IN_SSMCB] + (size_t)l * 768;
    const int lane = tid & 63, wave = tid >> 6;
    {
        const int ch = tid; const bf16_t* col = Qb + (size_t)t0 * QP + QC_XBC + ch;
        const float w0 = cw[ch], w1 = cw[768 + ch], w2 = cw[1536 + ch], w3 = cw[2304 + ch], bs = cbias[ch];
        float r1 = 0.f, r2 = 0.f, r3 = 0.f;
        if (t0 > 0) { r1 = bf2f(*(col - (size_t)QP)); r2 = bf2f(*(col - (size_t)2 * QP)); r3 = bf2f(*(col - (size_t)3 * QP)); }
        LAS unsigned char* dst = lds + L_XT + ch * 136;
#pragma unroll 4
        for (int s0 = 0; s0 < 64; s0 += 8) {
            bf16_t raw[8]; float v[8];
#pragma unroll
            for (int j = 0; j < 8; ++j) raw[j] = col[(size_t)(s0 + j) * QP];
#pragma unroll
            for (int j = 0; j < 8; ++j) { const float r0 = bf2f(raw[j]); v[j] = siluf_(w0 * r3 + w1 * r2 + w2 * r1 + w3 * r0 + bs); r3 = r2; r2 = r1; r1 = r0; }
            u32x2 o0, o1; o0.x = pk2(v[0], v[1]); o0.y = pk2(v[2], v[3]); o1.x = pk2(v[4], v[5]); o1.y = pk2(v[6], v[7]);
            *(LAS u32x2*)(dst + s0 * 2) = o0; *(LAS u32x2*)(dst + s0 * 2 + 8) = o1;
        }
    }
    {
        constexpr int NCH = OUT ? 256 : 128, PARTS = NTHREADS / NCH, RPP = 64 / PARTS;
        const int ch2 = tid % NCH, rs = (tid / NCH) * RPP;
        const bf16_t* col = Qb + (size_t)(t0 + rs) * QP + QC_XBC + 512 + ch2;
        const float w0 = cw[512 + ch2], w1 = cw[768 + 512 + ch2], w2 = cw[1536 + 512 + ch2], w3 = cw[2304 + 512 + ch2], bs = cbias[512 + ch2];
        float r1 = 0.f, r2 = 0.f, r3 = 0.f;
        if (t0 + rs > 0) { r1 = bf2f(*(col - (size_t)QP)); r2 = bf2f(*(col - (size_t)2 * QP)); r3 = bf2f(*(col - (size_t)3 * QP)); }
        const bool isB = ch2 < 128;
        LAS unsigned char* nat = lds + (isB ? L_BN + ch2 * 2 : L_CN + (ch2 - 128) * 2) + rs * 272;
        LAS unsigned char* tr = lds + L_BT + ch2 * 136 + rs * 2;
#pragma unroll
        for (int s0 = 0; s0 < RPP; s0 += 8) {
            bf16_t raw[8]; float v[8];
#pragma unroll
            for (int j = 0; j < 8; ++j) raw[j] = col[(size_t)(s0 + j) * QP];
#pragma unroll
            for (int j = 0; j < 8; ++j) { const float r0 = bf2f(raw[j]); v[j] = siluf_(w0 * r3 + w1 * r2 + w2 * r1 + w3 * r0 + bs); r3 = r2; r2 = r1; r1 = r0; }
            if (OUT) {
#pragma unroll
                for (int j = 0; j < 8; ++j) *(LAS unsigned short*)(nat + (s0 + j) * 272) = (unsigned short)f2bf(v[j]);
            } else {
                u32x2 o0, o1; o0.x = pk2(v[0], v[1]); o0.y = pk2(v[2], v[3]); o1.x = pk2(v[4], v[5]); o1.y = pk2(v[6], v[7]);
                *(LAS u32x2*)(tr + s0 * 2) = o0; *(LAS u32x2*)(tr + s0 * 2 + 8) = o1;
            }
        }
    }
    {
        const int r = tid >> 3, hh = tid & 7;
        const float dtr = ((const float*)(a->ws + WS_DT))[(size_t)(b * SEQ + t0 + r) * 8 + hh] + a->in[IN_DTB][l * 8 + hh];
        const float dtv = softplusf_(dtr);
        ((LAS float*)(lds + L_DTV))[r * 8 + hh] = dtv; ((LAS float*)(lds + L_ATAB))[hh * 64 + r] = -dtv * __expf(a->in[IN_ALOG][l * 8 + hh]);
    }
    if (OUT) ((LAS float*)(lds + L_NW))[tid] = a->in[IN_SSMNW][(size_t)l * 512 + tid];
    __syncthreads();
    {
        float v = ((LAS float*)(lds + L_ATAB))[wave * 64 + lane];
#pragma unroll
        for (int o = 1; o < 64; o <<= 1) { const float u = __shfl_up(v, o); if (lane >= o) v += u; }
        ((LAS float*)(lds + L_ACS))[lane * 8 + wave] = v;
    }
    __syncthreads();
}
__device__ __forceinline__ bf16x8 rd2x64(const LAS unsigned char* p) { const u32x2 lo = *(const LAS u32x2*)p, hi = *(const LAS u32x2*)(p + 8); u32x4 v; v.x = lo.x; v.y = lo.y; v.z = hi.x; v.w = hi.y; return __builtin_bit_cast(bf16x8, v); }
__device__ __forceinline__ bf16x8 rd2x64_gap(const LAS unsigned char* p) { const u32x2 lo = *(const LAS u32x2*)p, hi = *(const LAS u32x2*)(p + 16); u32x4 v; v.x = lo.x; v.y = lo.y; v.z = hi.x; v.w = hi.y; return __builtin_bit_cast(bf16x8, v); }

__device__ __forceinline__ void ssd2_pass1(KA a, int l, bf16_t* P, int unit, LAS unsigned char* lds, int tid) {
    const int b = unit / SSD_NCH, ck = unit % SSD_NCH, t0 = ck * SSD_CH;
    const bf16_t* Qb = P + Q_OFF + (size_t)b * SEQ * QP;
    ssd2_stage<false>(a, l, Qb, b, t0, lds, tid);
    const int lane = tid & 63, h = __builtin_amdgcn_readfirstlane(tid >> 6), g = h >> 2, c = lane & 31, hh = lane >> 5;
    const LAS float* ACS = (const LAS float*)(lds + L_ACS); const LAS float* DTV = (const LAS float*)(lds + L_DTV);
    const float acs_end = ACS[63 * 8 + h];
    f32x16 sacc[2][2];
#pragma unroll
    for (int i = 0; i < 16; ++i) { sacc[0][0][i] = 0.f; sacc[0][1][i] = 0.f; sacc[1][0][i] = 0.f; sacc[1][1][i] = 0.f; }
#pragma unroll
    for (int ks = 0; ks < 4; ++ks) {
        float wg[8];
#pragma unroll
        for (int j = 0; j < 8; ++j) { const int s = 16 * ks + 8 * hh + j; wg[j] = DTV[s * 8 + h] * __expf(acs_end - ACS[s * 8 + h]); }
        bf16x8 bfr[2];
#pragma unroll
        for (int nt = 0; nt < 2; ++nt) bfr[nt] = rd2x64(lds + L_BT + (g * 64 + c + 32 * nt) * 136 + (16 * ks + 8 * hh) * 2);
#pragma unroll
        for (int pt = 0; pt < 2; ++pt) {
            const LAS unsigned char* xp = lds + L_XT + (h * 64 + c + 32 * pt) * 136 + (16 * ks + 8 * hh) * 2;
            const u32x2 lo = *(const LAS u32x2*)xp, hi = *(const LAS u32x2*)(xp + 8);
            u32x4 o; o.x = pk2(bflo(lo.x) * wg[0], bfhi(lo.x) * wg[1]); o.y = pk2(bflo(lo.y) * wg[2], bfhi(lo.y) * wg[3]);
            o.z = pk2(bflo(hi.x) * wg[4], bfhi(hi.x) * wg[5]); o.w = pk2(bflo(hi.y) * wg[6], bfhi(hi.y) * wg[7]);
            const bf16x8 afr = __builtin_bit_cast(bf16x8, o);
#pragma unroll
            for (int nt = 0; nt < 2; ++nt) sacc[pt][nt] = __builtin_amdgcn_mfma_f32_32x32x16_bf16(afr, bfr[nt], sacc[pt][nt], 0, 0, 0);
        }
    }
    bf16_t* stp = (bf16_t*)(a->ws + WS_HM) + ((size_t)(b * SSD_NCH + ck) * 8 + h) * 4096;
#pragma unroll
    for (int pt = 0; pt < 2; ++pt)
#pragma unroll
        for (int nt = 0; nt < 2; ++nt)
#pragma unroll
            for (int i = 0; i < 16; ++i) stp[(32 * pt + (i & 3) + 8 * (i >> 2) + 4 * hh) * 64 + c + 32 * nt] = (bf16_t)f2bf(sacc[pt][nt][i]);
    if (lane == 0) ((float*)(a->ws + WS_CD))[(size_t)(b * SSD_NCH + ck) * 8 + h] = acs_end;
    __syncthreads();
}

__device__ __forceinline__ void ssd2_pass3(KA a, int l, bf16_t* P, int unit, LAS unsigned char* lds, int tid) {
    const int b = unit / SSD_NCH, ck = unit % SSD_NCH, t0 = ck * SSD_CH;
    bf16_t* Yb = P + Y_OFF + (size_t)b * SEQ * YP; const bf16_t* Qb = P + Q_OFF + (size_t)b * SEQ * QP;
    ssd2_stage<true>(a, l, Qb, b, t0, lds, tid);
    const int lane = tid & 63, h = __builtin_amdgcn_readfirstlane(tid >> 6), g = h >> 2, c = lane & 31, hh = lane >> 5;
    const LAS float* ACS = (const LAS float*)(lds + L_ACS); const LAS float* DTV = (const LAS float*)(lds + L_DTV);
    LAS float* SS = (LAS float*)(lds + L_SS); const LAS float* NW = (const LAS float*)(lds + L_NW);
    f32x16 acc[2][2];
    const float Dh = a->in[IN_SSMD][l * 8 + h];
    const bf16_t* prev = (const bf16_t*)(a->ws + WS_HM) + ((size_t)(b * SSD_NCH + ck) * 8 + h) * 4096;
#pragma unroll
    for (int tt = 0; tt < 2; ++tt) {
        asm volatile("" ::: "memory"); __builtin_amdgcn_sched_barrier(0);
        const int t = c + 32 * tt;
        const float acs_t = ACS[t * 8 + h];
        bf16x8 cfr[4];
#pragma unroll
        for (int ks = 0; ks < 4; ++ks) cfr[ks] = *(const LAS bf16x8*)(lds + L_CN + t * 272 + (g * 64 + 16 * ks + 8 * hh) * 2);
#pragma unroll
        for (int i = 0; i < 16; ++i) { acc[0][tt][i] = 0.f; acc[1][tt][i] = 0.f; }
#pragma unroll
        for (int st = 0; st <= tt; ++st) {
            f32x16 gm;
#pragma unroll
            for (int i = 0; i < 16; ++i) gm[i] = 0.f;
#pragma unroll
            for (int ks = 0; ks < 4; ++ks) {
                const bf16x8 bfr = *(const LAS bf16x8*)(lds + L_BN + (c + 32 * st) * 272 + (g * 64 + 16 * ks + 8 * hh) * 2);
                gm = __builtin_amdgcn_mfma_f32_32x32x16_bf16(bfr, cfr[ks], gm, 0, 0, 0);
            }
            unsigned wp[8];
#pragma unroll
            for (int i2 = 0; i2 < 8; ++i2) {
                float w2[2];
#pragma unroll
                for (int e = 0; e < 2; ++e) { const int i = 2 * i2 + e; const int sx = 32 * st + (i & 3) + 8 * (i >> 2) + 4 * hh;
                    const float v = gm[i] * __expf(acs_t - ACS[sx * 8 + h]) * DTV[sx * 8 + h];
                    w2[e] = (sx <= t) ? v : 0.f; }
                wp[i2] = pk2(w2[0], w2[1]);
            }
#pragma unroll
            for (int s2 = 0; s2 < 2; ++s2) {
                u32x4 wv; wv.x = wp[4 * s2]; wv.y = wp[4 * s2 + 1]; wv.z = wp[4 * s2 + 2]; wv.w = wp[4 * s2 + 3];
                const bf16x8 wfr = __builtin_bit_cast(bf16x8, wv);
#pragma unroll
                for (int pt = 0; pt < 2; ++pt) {
                    const bf16x8 xfr = rd2x64_gap(lds + L_XT + (h * 64 + c + 32 * pt) * 136 + (32 * st + 16 * s2 + 4 * hh) * 2);
                    acc[pt][tt] = __builtin_amdgcn_mfma_f32_32x32x16_bf16(xfr, wfr, acc[pt][tt], 0, 0, 0);
                }
            }
        }
        {
            const float et = __expf(acs_t);
#pragma unroll
            for (int ks = 0; ks < 4; ++ks) {
                const u32x4 cv = __builtin_bit_cast(u32x4, cfr[ks]); u32x4 o;
                o.x = pk2(bflo(cv.x) * et, bfhi(cv.x) * et); o.y = pk2(bflo(cv.y) * et, bfhi(cv.y) * et); o.z = pk2(bflo(cv.z) * et, bfhi(cv.z) * et); o.w = pk2(bflo(cv.w) * et, bfhi(cv.w) * et);
                const bf16x8 cs = __builtin_bit_cast(bf16x8, o);
#pragma unroll
                for (int pt = 0; pt < 2; ++pt) {
                    const bf16x8 pfr = *(const bf16x8*)(prev + (c + 32 * pt) * 64 + 16 * ks + 8 * hh);
                    acc[pt][tt] = __builtin_amdgcn_mfma_f32_32x32x16_bf16(pfr, cs, acc[pt][tt], 0, 0, 0);
                }
            }
        }
        const u32x4* zrow = (const u32x4*)(Yb + (size_t)(t0 + t) * YP + YC_C + h * 64);
        float ss = 0.f;
#pragma unroll
        for (int pt = 0; pt < 2; ++pt)
#pragma unroll
            for (int q = 0; q < 4; ++q) {
                const u32x4 zr = zrow[4 * pt + q];
                const unsigned zlo = hh ? zr.z : zr.x, zhi = hh ? zr.w : zr.y;
                const float zv[4] = {bflo(zlo), bfhi(zlo), bflo(zhi), bfhi(zhi)};
#pragma unroll
                for (int r = 0; r < 4; ++r) { const int i = 4 * q + r, p = 32 * pt + 8 * q + 4 * hh + r;
                    const float xv = bf2f(*(const LAS unsigned short*)(lds + L_XT + (h * 64 + p) * 136 + t * 2));
                    const float yz = (acc[pt][tt][i] + Dh * xv) * siluf_(zv[r]);
                    acc[pt][tt][i] = yz; ss += yz * yz; }
            }
        ss += __shfl_xor(ss, 32);
        if (hh == 0) SS[t * 8 + h] = ss;
    }
    __syncthreads();
#pragma unroll
    for (int tt = 0; tt < 2; ++tt) {
        const int t = c + 32 * tt;
        const float tot = (SS[t * 8 + g * 4 + 0] + SS[t * 8 + g * 4 + 1]) + (SS[t * 8 + g * 4 + 2] + SS[t * 8 + g * 4 + 3]);
        const float rs = 1.0f / sqrtf(tot * (1.f / 256.f) + EPS);
        bf16_t* orow = Yb + (size_t)(t0 + t) * YP + YC_C + h * 64;
#pragma unroll
        for (int pt = 0; pt < 2; ++pt)
#pragma unroll
            for (int q = 0; q < 4; ++q) { const int p0 = 32 * pt + 8 * q + 4 * hh; const f32x4 nw = *(const LAS f32x4*)(NW + h * 64 + p0);
                u32x2 o; o.x = pk2(acc[pt][tt][4 * q + 0] * rs * nw[0], acc[pt][tt][4 * q + 1] * rs * nw[1]); o.y = pk2(acc[pt][tt][4 * q + 2] * rs * nw[2], acc[pt][tt][4 * q + 3] * rs * nw[3]);
                *(u32x2*)(orow + p0) = o; }
    }
    __syncthreads();
}
__device__ __forceinline__ void ssd2_scan_phase(KA a, int tid) {
    bf16_t* STATES = (bf16_t*)(a->ws + WS_HM); const float* CDp = (const float*)(a->ws + WS_CD);
    for (int it = blockIdx.x * NTHREADS + tid; it < BATCH * 8 * 4096; it += gridDim.x * NTHREADS) {
        const int e = it & 4095, bh = it >> 12, b = bh >> 3, h = bh & 7;
        float run = 0.f;
#pragma unroll 32
        for (int cc = 0; cc < SSD_NCH; ++cc) {
            bf16_t* p = STATES + ((size_t)(b * SSD_NCH + cc) * 8 + h) * 4096 + e;
            const float sv = bf2f(*p); const float dec = __expf(CDp[(size_t)(b * SSD_NCH + cc) * 8 + h]);
            *p = (bf16_t)f2bf(run); run = run * dec + sv;
        }
    }
}

#define XB_TMO      128
#define XB_XCNT(j)  (256  + 64 * (j))
#define XB_XSUB(j)  (1280 + 64 * (j))
#define XB_XGEN(j)  (2304 + 64 * (j))
#define XB_TOP      3328
#define XB_TOPGEN   3392
#define XCD_BAR_WORDS 3456
#define XB_SPIN_CAP (1u << 22)
__device__ __forceinline__ unsigned xb_ld(unsigned* p)              { return __hip_atomic_load(p, __ATOMIC_RELAXED, __HIP_MEMORY_SCOPE_AGENT); }
__device__ __forceinline__ unsigned xb_add(unsigned* p, unsigned v) { return __hip_atomic_fetch_add(p, v, __ATOMIC_RELAXED, __HIP_MEMORY_SCOPE_AGENT); }
__device__ __forceinline__ unsigned xb_xcc_id() { return (unsigned)__builtin_amdgcn_s_getreg((3 << 11) | 20) & 0xFu; }
#define XB_SPIN(cond, bar) do { unsigned _sp = 0; while (cond) { __builtin_amdgcn_s_sleep(1); \
    if ((++_sp & 255u) == 0u) { if (xb_ld(&(bar)[XB_TMO])) break; if (_sp > XB_SPIN_CAP) { atomicAdd(&(bar)[XB_TMO], 1u); break; } } } } while (0)
struct XcdBarrier { unsigned* bar; unsigned x; volatile LAS unsigned* st; };
__device__ __forceinline__ XcdBarrier xcd_barrier_post(unsigned* bar, volatile LAS unsigned* st) {
    XcdBarrier b; b.bar = bar; b.x = xb_xcc_id(); b.st = st;
    if (threadIdx.x == 0) (void)xb_add(&bar[XB_XCNT(b.x)], 1u);
    return b;
}
__device__ __forceinline__ void xcd_barrier_complete(unsigned* bar, unsigned x, unsigned& nloc, unsigned& nx) {
    const unsigned G = gridDim.x * gridDim.y * gridDim.z;
    unsigned sum, cnt, mine, sp = 0u;
    for (;;) {
        sum = 0u; cnt = 0u; mine = 0u;
#pragma unroll 1
        for (unsigned j = 0; j < 16; ++j) { const unsigned c = xb_ld(&bar[XB_XCNT(j)]); sum += c; cnt += (c > 0u) ? 1u : 0u; mine = (j == x) ? c : mine; }
        if (sum == G) break;
        __builtin_amdgcn_s_sleep(1);
        if ((++sp & 255u) == 0u) { if (xb_ld(&bar[XB_TMO])) break; if (sp > XB_SPIN_CAP) { atomicAdd(&bar[XB_TMO], 1u); break; } }
    }
    nloc = mine > 0u ? mine : 1u; nx = cnt > 0u ? cnt : 1u;
}
__device__ __forceinline__ void xcd_barrier(const XcdBarrier& b) {
    asm volatile("s_waitcnt vmcnt(0)" ::: "memory");
    __syncthreads();
    if (threadIdx.x == 0) {
        unsigned* bar = b.bar;
        __builtin_amdgcn_s_waitcnt(0);
        unsigned nloc = b.st[0], nx = b.st[1];
        if (nloc == 0u) { xcd_barrier_complete(bar, b.x, nloc, nx); b.st[0] = nloc; b.st[1] = nx; }
        const unsigned old = xb_add(&bar[XB_XSUB(b.x)], 1u);
        const unsigned gen = old / nloc;
        if (old + 1u == (gen + 1u) * nloc) {
            __builtin_amdgcn_fence(__ATOMIC_RELEASE, "agent");
            asm volatile("s_waitcnt vmcnt(0)" ::: "memory");
            const unsigned og = xb_add(&bar[XB_TOP], 1u);
            const unsigned tg = og / nx;
            if (og + 1u == (tg + 1u) * nx) xb_add(&bar[XB_TOPGEN], 1u);
            else XB_SPIN(xb_ld(&bar[XB_TOPGEN]) == tg, bar);
            __builtin_amdgcn_fence(__ATOMIC_ACQUIRE, "agent");
            xb_add(&bar[XB_XGEN(b.x)], 1u);
            asm volatile("s_waitcnt vmcnt(0)" ::: "memory");
        } else {
            XB_SPIN(xb_ld(&bar[XB_XGEN(b.x)]) == gen, bar);
            __builtin_amdgcn_fence(__ATOMIC_ACQUIRE, "agent");
            asm volatile("s_waitcnt vmcnt(0)" ::: "memory");
        }
    }
    __syncthreads();
}

constexpr int PH_PER_LAYER = 11;

#define SEAM(k) xcd_barrier(xbar)
template <int l>
__device__ __forceinline__ void layer_phases(LAS unsigned char* lds, const XcdBarrier xbar, cg::grid_group& grid, const int wave, const int G, const int bx, const int gw, const int NGW) {
    const int pb = 1 + l * PH_PER_LAYER; int tid, lane;
        if (l == 0) {
            {
                KA ka = ka_fresh(); tid = threadIdx.x; asm volatile("" : "+v"(tid)); lane = tid & 63; unsigned char* ws = ka->ws; bf16_t* HM = (bf16_t*)(ws + WS_HM); const float* modl = (const float*)(ws + WS_MOD) + (size_t)l * 2 * 6144;
                const float* xcur = ka->in[IN_X]; const float* gpm = ka->in[IN_GPM] + (size_t)l * D;
                for (int m = gw; m < M; m += NGW) { const int b = m / SEQ; const float* md = modl + (size_t)b * 6144;
                    prenorm_row(xcur + (size_t)m * D, gpm, md + 1024, md + 0, HM + (size_t)m * D, lane); }
            }
            SEAM(pb + 0);
        }
        {
            KA ka = ka_fresh(); tid = threadIdx.x; asm volatile("" : "+v"(tid)); lane = tid & 63; unsigned char* ws = ka->ws; unsigned char* wl = ws + WS_W + (size_t)l * W_LAYER;
            pg8::Gemm g{(const bf16_t*)(ws + WS_HM), (const bf16_t*)(wl + W_IN), M, NPAD, D, D, D}; pg8::StaticOrder S; S.init(M, NPAD, G, bx);
            pg8::EpiProj E{(bf16_t*)(ws + WS_P), (float*)(ws + WS_DT)};
            pg8::gemm_phase<pg8::EpiProj>(lds, g, S, E);
        }
        SEAM(pb + 1);
        {
            KA ka = ka_fresh(); tid = threadIdx.x; asm volatile("" : "+v"(tid)); lane = tid & 63; bf16_t* P = (bf16_t*)(ka->ws + WS_P);
            for (int u = bx; u < BATCH * SSD_NCH; u += G) ssd2_pass1(ka, l, P, u, lds, tid);
            __syncthreads();
            tid = threadIdx.x; asm volatile("" : "+v"(tid)); lane = tid & 63;
            for (int u = gw; u < BATCH * 4 * 512; u += NGW) attn_mfma_unit(P, u, lds + wave * 16384, lane);
            tid = threadIdx.x; asm volatile("" : "+v"(tid)); lane = tid & 63;
            if (G < 2) shortconv_phase(ka, l, P, tid, bx, G);
        }
        SEAM(pb + 2);
        { KA ka = ka_fresh(); tid = threadIdx.x; asm volatile("" : "+v"(tid)); lane = tid & 63; ssd2_scan_phase(ka, tid);
            if (l == 0 && G >= 2) {
                const int nscan = (BATCH * 8 * 4096) / NTHREADS < G ? (BATCH * 8 * 4096) / NTHREADS : 0;
                if (bx >= nscan) { LAS float* scr = (LAS float*)(lds + wave * 16384);
                    for (int it = (bx - nscan) * NWAVES + wave; it < TR_PER_LAYER; it += (G - nscan) * NWAVES) tr_dispatch(ka, TR_PER_LAYER + it, scr, lane); } }
            if (G >= 2) {
                const int nscan = (BATCH * 8 * 4096) / NTHREADS < G ? (BATCH * 8 * 4096) / NTHREADS : 0;
                if (nscan == 0) shortconv_phase(ka, l, (bf16_t*)(ka->ws + WS_P), tid, bx, G); else if (bx >= nscan) shortconv_phase(ka, l, (bf16_t*)(ka->ws + WS_P), tid, bx - nscan, G - nscan); } }
        SEAM(pb + 3);
        { KA ka = ka_fresh(); tid = threadIdx.x; asm volatile("" : "+v"(tid)); lane = tid & 63; bf16_t* P = (bf16_t*)(ka->ws + WS_P); for (int u = bx; u < BATCH * SSD_NCH; u += G) ssd2_pass3(ka, l, P, u, lds, tid); }
        SEAM(pb + 4);
        {
            KA ka = ka_fresh(); tid = threadIdx.x; asm volatile("" : "+v"(tid)); lane = tid & 63; unsigned char* ws = ka->ws; unsigned char* wl = ws + WS_W + (size_t)l * W_LAYER; bf16_t* P = (bf16_t*)(ws + WS_P);
            pg8::Gemm g{P + Y_OFF, (const bf16_t*)(wl + W_OUT3), M, D, D, YP, D}; pg8::StaticOrder S; S.init(M, D, G, bx);
            pg8::EpiGate3 E{(bf16_t*)(ws + WS_HM), P + G_OFF};
            pg8::gemm_phase<pg8::EpiGate3>(lds, g, S, E);
        }
        SEAM(pb + 5);
        {
            KA ka = ka_fresh(); tid = threadIdx.x; asm volatile("" : "+v"(tid)); lane = tid & 63; unsigned char* ws = ka->ws; unsigned char* wl = ws + WS_W + (size_t)l * W_LAYER;
            pg8::Gemm g{(const bf16_t*)(ws + WS_HM), (const bf16_t*)(wl + W_O), M, D, D, D, D}; pg8::StaticOrder S; S.init(M, D, G, bx);
            const float* modl = (const float*)(ws + WS_MOD) + (size_t)l * 2 * 6144;
            pg8::EpiResNorm<(l != 0), true> E{(l == 0) ? (const void*)ka->in[IN_X] : (const void*)ka->out, (void*)(ws + WS_P), modl + 2048, ka->in[IN_GPOM] + (size_t)l * D, 1, ka->in[IN_GPF] + (size_t)l * D, modl + 4096, modl + 3072,
                              (bf16_t*)(ws + WS_P + P_H2),
                              pg8::PanelSq{(float*)(ws + WS_XBUF) + (size_t)(l * 4 + 0) * 131072, (unsigned*)(ws + WS_PCNT), 32u * (unsigned)(l * 4 + 1)},
                              pg8::PanelSq{(float*)(ws + WS_XBUF) + (size_t)(l * 4 + 1) * 131072, (unsigned*)(ws + WS_PCNT), 32u * (unsigned)(l * 4 + 2)}};
            pg8::gemm_phase<pg8::EpiResNorm<(l != 0), true>>(lds, g, S, E);
        }
        SEAM(pb + 6);
        {
            KA ka = ka_fresh(); tid = threadIdx.x; asm volatile("" : "+v"(tid)); lane = tid & 63; unsigned char* ws = ka->ws; unsigned char* wl = ws + WS_W + (size_t)l * W_LAYER;
            pg8::Gemm g{(const bf16_t*)(ws + WS_P + P_H2), (const bf16_t*)(wl + W_FI), M, 2 * FFN, D, D, D}; pg8::StaticOrder S; S.init(M, 2 * FFN, G, bx);
            pg8::EpiSwiGLU E{(bf16_t*)(ws + WS_P + P_ACT)};
            pg8::gemm_phase<pg8::EpiSwiGLU>(lds, g, S, E);
        }
        SEAM(pb + 8);
        {
            KA ka = ka_fresh(); tid = threadIdx.x; asm volatile("" : "+v"(tid)); lane = tid & 63; unsigned char* ws = ka->ws; unsigned char* wl = ws + WS_W + (size_t)l * W_LAYER;
            pg8::Gemm g{(const bf16_t*)(ws + WS_P + P_ACT), (const bf16_t*)(wl + W_FO), M, D, FFN, FFN, FFN}; pg8::StaticOrder S; S.init(M, D, G, bx);
            constexpr bool nxt = (l + 1 < DEPTH); constexpr int ln = nxt ? l + 1 : l;
            const float* modl = (const float*)(ws + WS_MOD) + (size_t)l * 2 * 6144; const float* modn = (const float*)(ws + WS_MOD) + (size_t)ln * 2 * 6144;
            pg8::EpiResNorm<true, nxt> E{(const void*)(ws + WS_P), (void*)ka->out, modl + 5120, ka->in[IN_GPOF] + (size_t)l * D, nxt ? 1 : 0, ka->in[IN_GPM] + (size_t)ln * D, modn + 1024, modn + 0,
                              (bf16_t*)(ws + WS_HM),
                              pg8::PanelSq{(float*)(ws + WS_XBUF) + (size_t)(l * 4 + 2) * 131072, (unsigned*)(ws + WS_PCNT), 32u * (unsigned)(l * 4 + 3)},
                              pg8::PanelSq{(float*)(ws + WS_XBUF) + (size_t)(l * 4 + 3) * 131072, (unsigned*)(ws + WS_PCNT), 32u * (unsigned)(l * 4 + 4)}};
            pg8::gemm_phase<pg8::EpiResNorm<true, nxt>>(lds, g, S, E);
        }
        if (l + 1 < DEPTH) SEAM(pb + 9);
}

__global__ void __launch_bounds__(NTHREADS, 2) fwd_kernel(Args args_unused) {
    extern __shared__ __attribute__((aligned(16))) unsigned char lds_raw[];
    LAS unsigned char* lds = (LAS unsigned char*)lds_raw;
    int tid = threadIdx.x; asm volatile("" : "+v"(tid));
    int lane = tid & 63; const int wave = __builtin_amdgcn_readfirstlane(tid >> 6);
    const int G = gridDim.x, bx = blockIdx.x;
    const int gw = bx * NWAVES + wave, NGW = G * NWAVES;
    cg::grid_group grid = cg::this_grid();
    if (tid < 16) ((LAS unsigned*)(lds + LDS_BYTES - 64))[tid] = 0u;
    __syncthreads();
    XcdBarrier xbar; { KA ka = ka_fresh(); xbar = xcd_barrier_post((unsigned*)(ka->ws + WS_BAR), (volatile LAS unsigned*)(lds + LDS_BYTES - 64)); }

    if (gridDim.y == 12345u) grid.sync();
    {
        KA ka = ka_fresh(); tid = threadIdx.x; asm volatile("" : "+v"(tid)); lane = tid & 63;
        for (int it = bx; it < 192; it += G) mod_item(ka, it, (LAS float*)lds, tid);
        LAS float* scr = (LAS float*)(lds + wave * 16384);
        for (int it = gw; it < TR_PER_LAYER; it += NGW) tr_dispatch(ka, it, scr, lane);
    }
    SEAM(0);

    layer_phases<0>(lds, xbar, grid, wave, G, bx, gw, NGW);
    layer_phases<1>(lds, xbar, grid, wave, G, bx, gw, NGW);
#undef SEAM
}

extern "C" void kernel_launch(void* const* d_in, const int* in_sizes, int n_in, void* d_out, int out_size, void* d_ws, size_t ws_size, hipStream_t stream) {
    static int grid = 0;
    if (grid == 0) {
        if (n_in != 22 || out_size != M * D || ws_size < WS_END) { fprintf(stderr, "kernel_launch: unexpected shapes (n_in %d, out %d, ws %zu)\n", n_in, out_size, ws_size); grid = -1; return; }
        int dev = 0, cus = 0, per_cu = 0;
        hipGetDevice(&dev); hipDeviceGetAttribute(&cus, hipDeviceAttributeMultiprocessorCount, dev);
        if (hipFuncSetAttribute((const void*)fwd_kernel, hipFuncAttributeMaxDynamicSharedMemorySize, LDS_BYTES) != hipSuccess) { fprintf(stderr, "kernel_launch: hipFuncSetAttribute failed\n"); grid = -1; return; }
        if (hipOccupancyMaxActiveBlocksPerMultiprocessor(&per_cu, (const void*)fwd_kernel, NTHREADS, LDS_BYTES) != hipSuccess || per_cu < 1) { fprintf(stderr, "kernel_launch: occupancy query says %d\n", per_cu); per_cu = 1; }
        (void)hipGetLastError();
        grid = cus >= 256 ? 256 : cus;
    }
    if (grid < 0) return;
    if (hipMemsetAsync((unsigned char*)d_ws + WS_BAR, 0, 16384 + 32768, stream) != hipSuccess) { fprintf(stderr, "kernel_launch: memset failed\n"); return; }
    Args a{};
    for (int i = 0; i < 22; ++i) a.in[i] = (const float*)d_in[i];
    a.out = (float*)d_out; a.ws = (unsigned char*)d_ws;
    void* kargs[] = {&a};
    hipError_t e = hipLaunchCooperativeKernel((const void*)fwd_kernel, dim3(grid), dim3(NTHREADS), kargs, LDS_BYTES, stream);
    if (e != hipSuccess) fprintf(stderr, "kernel_launch: cooperative launch failed: %s (grid %d)\n", hipGetErrorString(e), grid);
}
```
